# Optimizing an MI355X kernel written in HIP

```python
import math
import jax, jax.numpy as jnp
from jax import lax
import numpy as np

D_MODEL = 1024
BATCH = 2
SEQ = 8192
DEPTH = 2
DEC_BATCH = 8
DEC_SEQ = 32
PAST_LEN = 2048

CHUNK = 64
N_A = DEPTH // 2
N_B = DEPTH - N_A
POOL_WINDOWS = (2, 4, 8, 16)
POOL_GROUP = D_MODEL // 8
POOL_WIDTH = 4 * POOL_GROUP
POOL_HIST = max(POOL_WINDOWS) - 1
N_DIFF_HEADS = 4
DIFF_HEAD_DIM = D_MODEL // 16
DIFF_V_DIM = 2 * DIFF_HEAD_DIM
DIFF_Q_WIDTH = N_DIFF_HEADS * 2 * DIFF_HEAD_DIM
DIFF_OUT_WIDTH = N_DIFF_HEADS * DIFF_V_DIM
N_MEM = 256
N_MEM_HEADS = 4
MEM_HEAD_DIM = D_MODEL // 8
MEM_WIDTH = N_MEM_HEADS * MEM_HEAD_DIM
MIX_IN = POOL_WIDTH + MEM_WIDTH
MIX_OUT = POOL_WIDTH + MEM_WIDTH
D_FF = 4 * D_MODEL
Q_BLOCK = 128
EPS = 1e-6

kernel_name = "yoco_pool_diffattn_streaming_step"


def rmsnorm(x, g):
    xf = x.astype(jnp.float32)
    y = xf * lax.rsqrt(jnp.mean(xf * xf, axis=-1, keepdims=True) + EPS)
    return (y * g.astype(jnp.float32)).astype(x.dtype)


def sq_relu_mlp(x, w1, w2):
    h = jax.nn.relu(x @ w1)
    return (h * h) @ w2


def lambda_init(layer_idx):
    return 0.8 - 0.6 * math.exp(-0.3 * layer_idx)


def alibi_slopes():
    return 2.0 ** (-8.0 * jnp.arange(1, N_DIFF_HEADS + 1, dtype=jnp.float32) / N_DIFF_HEADS)


def pool_mix(u, hist, pos, w_grp, scale):
    B, T, P = u.shape
    full = jnp.concatenate([hist, u], axis=1).astype(jnp.float32)
    cs = jnp.concatenate([jnp.zeros((B, 1, P), jnp.float32), jnp.cumsum(full, axis=1)], axis=1)
    end = cs[:, POOL_HIST + 1:]
    uf = u.astype(jnp.float32)
    outs = []
    for g, w in enumerate(POOL_WINDOWS):
        sl = slice(g * POOL_GROUP, (g + 1) * POOL_GROUP)
        start = cs[:, POOL_HIST + 1 - w: POOL_HIST + 1 - w + T, sl]
        cnt = jnp.minimum(pos + 1, w).astype(jnp.float32)[None, :, None]
        d = ((end[..., sl] - start) / cnt - uf[..., sl]).astype(u.dtype)
        outs.append(d @ w_grp[g])
    return jnp.concatenate(outs, axis=-1) * scale


def mem_kv(mem, g, w):
    B = mem.shape[0]
    kv = rmsnorm(mem, g) @ w
    k, v = jnp.split(kv, 2, axis=-1)
    return (k.reshape(B, N_MEM, N_MEM_HEADS, MEM_HEAD_DIM),
            v.reshape(B, N_MEM, N_MEM_HEADS, MEM_HEAD_DIM))


def mem_attend(q, k, v):
    B, T = q.shape[:2]
    s = jnp.einsum('bthd,bmhd->bhtm', q, k).astype(jnp.float32) * (MEM_HEAD_DIM ** -0.5)
    p = jax.nn.softmax(s, axis=-1).astype(v.dtype)
    return jnp.einsum('bhtm,bmhd->bthd', p, v).reshape(B, T, MEM_WIDTH)


def diff_core(q, k, v, q_pos, k_pos, lam, slopes):
    s = jnp.einsum('bqhcd,bkhcd->cbhqk', q, k).astype(jnp.float32) * (DIFF_HEAD_DIM ** -0.5)
    dist = jnp.abs(q_pos[:, None] - k_pos[None, :]).astype(jnp.float32)
    bias = -slopes[:, None, None] * dist[None]
    vis = (k_pos[None, :] // CHUNK) <= (q_pos[:, None] // CHUNK)
    s = jnp.where(vis, s + bias, -jnp.inf)
    p = jax.nn.softmax(s, axis=-1)
    a = p[0] - lam * p[1]
    return jnp.einsum('bhqk,bkhe->bqhe', a.astype(v.dtype), v)


def diff_attn_blocks(q, k, v, lam, slopes):
    B, T = q.shape[:2]
    nb = T // Q_BLOCK
    qb = q.reshape(B, nb, Q_BLOCK, N_DIFF_HEADS, 2, DIFF_HEAD_DIM).transpose(1, 0, 2, 3, 4, 5)
    k_pos = jnp.arange(T)

    def one(args):
        qi, i = args
        q_pos = i * Q_BLOCK + jnp.arange(Q_BLOCK)
        return diff_core(qi, k, v, q_pos, k_pos, lam, slopes)

    o = lax.map(one, (qb, jnp.arange(nb)))
    return o.transpose(1, 0, 2, 3, 4).reshape(B, T, N_DIFF_HEADS, DIFF_V_DIM)


def trunk(x, pos, pool_hist, mem_k, mem_v, past_k, past_v, blocked,
          g_attn, w_in, w_out, g_ffn, w_ff1, w_ff2, w_pool, pool_scale,
          lambda_qk, g_subln, g_kv, w_kv, g_final):
    B, T, _ = x.shape
    P0 = past_k.shape[1]
    slopes = alibi_slopes()
    new_pool = []
    new_k = new_v = k_all = v_all = None
    for l in range(DEPTH):
        h = rmsnorm(x, g_attn[l])
        z = h @ w_in[l]
        mix, qm = z[..., :MIX_IN - MEM_WIDTH], z[..., MIX_IN - MEM_WIDTH:]
        m_out = mem_attend(qm.reshape(B, T, N_MEM_HEADS, MEM_HEAD_DIM), mem_k[l], mem_v[l])
        if l < N_A:
            hist = pool_hist[l]
            new_pool.append(jnp.concatenate([hist, mix], axis=1)[:, -POOL_HIST:])
            t_out = pool_mix(mix, hist, pos, w_pool[l], pool_scale[l])
        else:
            b = l - N_A
            if new_k is None:
                kv = rmsnorm(x, g_kv) @ w_kv
                kk, vv = jnp.split(kv, 2, axis=-1)
                new_k = kk.reshape(B, T, N_DIFF_HEADS, DIFF_V_DIM)
                new_v = vv.reshape(B, T, N_DIFF_HEADS, DIFF_V_DIM)
                k_all = jnp.concatenate([past_k, new_k], axis=1).reshape(
                    B, P0 + T, N_DIFF_HEADS, 2, DIFF_HEAD_DIM)
                v_all = jnp.concatenate([past_v, new_v], axis=1)
            lq = lambda_qk[b].astype(jnp.float32)
            lam_i = lambda_init(l)
            lam = jnp.exp(jnp.sum(lq[0] * lq[1])) - jnp.exp(jnp.sum(lq[2] * lq[3])) + lam_i
            q = mix.reshape(B, T, N_DIFF_HEADS, 2, DIFF_HEAD_DIM)
            if blocked:
                o = diff_attn_blocks(q, k_all, v_all, lam, slopes)
            else:
                o = diff_core(q, k_all, v_all, pos, jnp.arange(P0 + T), lam, slopes)
            o = rmsnorm(o, g_subln[b]) * (1.0 - lam_i)
            t_out = o.reshape(B, T, DIFF_OUT_WIDTH)
        x = x + jnp.concatenate([t_out, m_out], axis=-1) @ w_out[l]
        x = x + sq_relu_mlp(rmsnorm(x, g_ffn[l]), w_ff1[l], w_ff2[l])
    return rmsnorm(x, g_final), jnp.stack(new_pool), new_k, new_v


def setup_inputs(seed: int = 0) -> dict:
    key = jax.random.key(seed)
    ks = iter(jax.random.split(key, 32))
    f32 = jnp.float32
    nrm = lambda shape, s=1.0: jax.random.normal(next(ks), shape, f32) * s
    gain = lambda shape: 1.0 + 0.05 * jax.random.normal(next(ks), shape, f32)
    return {
        "x_prompt": nrm((BATCH, SEQ, D_MODEL)),
        "x_sample": nrm((DEC_BATCH, DEC_SEQ, D_MODEL)),
        "mem_prompt": nrm((BATCH, N_MEM, D_MODEL)),
        "cache_k": nrm((DEC_BATCH, PAST_LEN, N_DIFF_HEADS, DIFF_V_DIM)),
        "cache_v": nrm((DEC_BATCH, PAST_LEN, N_DIFF_HEADS, DIFF_V_DIM)),
        "cache_mem_k": nrm((DEPTH, DEC_BATCH, N_MEM, N_MEM_HEADS, MEM_HEAD_DIM)),
        "cache_mem_v": nrm((DEPTH, DEC_BATCH, N_MEM, N_MEM_HEADS, MEM_HEAD_DIM)),
        "state_pool": nrm((N_A, DEC_BATCH, POOL_HIST, POOL_WIDTH)),
        "g_attn": gain((DEPTH, D_MODEL)),
        "w_in": nrm((DEPTH, D_MODEL, MIX_IN), D_MODEL ** -0.5),
        "w_out": nrm((DEPTH, MIX_OUT, D_MODEL), MIX_OUT ** -0.5),
        "g_mem": gain((DEPTH, D_MODEL)),
        "w_mem_kv": nrm((DEPTH, D_MODEL, 2 * MEM_WIDTH), D_MODEL ** -0.5),
        "g_ffn": gain((DEPTH, D_MODEL)),
        "w_ff1": nrm((DEPTH, D_MODEL, D_FF), D_MODEL ** -0.5),
        "w_ff2": nrm((DEPTH, D_FF, D_MODEL), D_FF ** -0.5),
        "w_pool": nrm((N_A, 4, POOL_GROUP, POOL_GROUP), POOL_GROUP ** -0.5),
        "pool_scale": gain((N_A, POOL_WIDTH)),
        "lambda_qk": nrm((N_B, 4, DIFF_HEAD_DIM), 0.1),
        "g_subln": gain((N_B, DIFF_V_DIM)),
        "g_kv": gain((D_MODEL,)),
        "w_kv": nrm((D_MODEL, 2 * N_DIFF_HEADS * DIFF_V_DIM), D_MODEL ** -0.5),
        "g_final": gain((D_MODEL,)),
    }


def reference(x_prompt, x_sample, mem_prompt, cache_k, cache_v, cache_mem_k, cache_mem_v, state_pool,
              g_attn, w_in, w_out, g_mem, w_mem_kv, g_ffn, w_ff1, w_ff2, w_pool, pool_scale,
              lambda_qk, g_subln, g_kv, w_kv, g_final):
    weights = (g_attn, w_in, w_out, g_ffn, w_ff1, w_ff2, w_pool, pool_scale,
               lambda_qk, g_subln, g_kv, w_kv, g_final)
    B, T, _ = x_prompt.shape
    mks, mvs = [], []
    for l in range(DEPTH):
        mk, mv = mem_kv(mem_prompt, g_mem[l], w_mem_kv[l])
        mks.append(mk)
        mvs.append(mv)
    mem_k_prompt = jnp.stack(mks)
    mem_v_prompt = jnp.stack(mvs)
    hist0 = jnp.zeros((N_A, B, POOL_HIST, POOL_WIDTH), x_prompt.dtype)
    past0 = jnp.zeros((B, 0, N_DIFF_HEADS, DIFF_V_DIM), x_prompt.dtype)
    y_prompt, pool_prompt, k_prompt, v_prompt = trunk(
        x_prompt, jnp.arange(T), hist0, mem_k_prompt, mem_v_prompt, past0, past0, True, *weights)
    P0 = cache_k.shape[1]
    Ts = x_sample.shape[1]
    y_sample, pool_sample, k_sample, v_sample = trunk(
        x_sample, P0 + jnp.arange(Ts), state_pool, cache_mem_k, cache_mem_v, cache_k, cache_v, False, *weights)
    return (y_prompt, y_sample, mem_k_prompt, mem_v_prompt, pool_prompt, k_prompt, v_prompt,
            pool_sample, k_sample, v_sample)
```

```cpp
#include <hip/hip_runtime.h>
#include <hip/hip_cooperative_groups.h>
#include <cstdio>
#include <cstdint>
namespace cg = cooperative_groups;


__device__ __forceinline__ int opq_tid() { int t = threadIdx.x; asm volatile("" : "+v"(t)); return t; }
#ifndef N_LAUNCHES
#define N_LAUNCHES 12
#endif

namespace pg8 {
#define PG8_LAS __attribute__((address_space(3)))
typedef unsigned short bf16_t;
typedef short bf16x8 __attribute__((ext_vector_type(8)));
typedef float f32x4 __attribute__((ext_vector_type(4)));
typedef unsigned u32x4 __attribute__((ext_vector_type(4)));
constexpr int BM = 256, BK = 64, HALF = 128, HTB = HALF * BK * 2  , STAGE_BYTES = 8 * HTB, NXCD = 8, WGM = 8;

__host__ __device__ __forceinline__ int lds_byte(int r, int c) { const int st = (r >> 4) * 2 + (c >> 5), rr = r & 15, cc = c & 31, ob = rr * 64 + cc * 2; return st * 1024 + (ob ^ (((ob >> 9) & 1) << 5)); }
__host__ __device__ __forceinline__ void stage_rc(int b, int& R, int& C) { const int st = b / 1024, sb = b % 1024, swz = sb ^ (((sb >> 9) & 1) << 5); R = (st >> 1) * 16 + swz / 64; C = (st & 1) * 32 + (swz % 64) / 2; }
__host__ __device__ __forceinline__ int perm32(int rho) { const int n = rho >> 4, i = rho & 15; return 8 * (i >> 2) + 4 * n + (i & 3); }

struct Unit { int pm, pn; };
struct Gemm { const bf16_t* A; const bf16_t* Bt; int M, N, K; };

struct StaticOrder {
    int nM, nN, nwg, G, c;
    __host__ __device__ void init(int M, int N, int G_, int c_) { nM = M / BM; nN = N / BM; nwg = nM * nN; G = G_; c = c_; }
    __host__ __device__ bool next(int i, Unit& u) const {
        const long L = (long)i * G + c; if (L >= nwg) return false;
        int wgid = (int)L; { const int q = nwg / NXCD, r = nwg % NXCD, xcd = wgid % NXCD, off = wgid / NXCD; wgid = (xcd < r ? xcd * (q + 1) : r * (q + 1) + (xcd - r) * q) + off; }
        const int nig = WGM * nN, gid = wgid / nig, fm = gid * WGM, gsz = (nM - fm) < WGM ? (nM - fm) : WGM;
        u.pm = fm + ((wgid % nig) % gsz); u.pn = (wgid % nig) / gsz; return true;
    }
    __device__ __forceinline__ void a_ready(const Unit&) const {}
    __device__ __forceinline__ void done(const Unit&) const {}
};

typedef float f32x2 __attribute__((ext_vector_type(2)));
typedef __bf16 bf16x2v __attribute__((ext_vector_type(2)));
__device__ __forceinline__ unsigned cvt_pk_bf16(float lo, float hi) { const f32x2 f = {lo, hi}; return __builtin_bit_cast(unsigned, __builtin_convertvector(f, bf16x2v)); }
}
namespace pg8 {
template <class Epi, class Sched, bool ALIGN_EPI = false, bool SP2 = false>
__device__ __forceinline__ void gemm_phase(PG8_LAS unsigned char* lds, const Gemm g, const Sched& S, const Epi& E) {
    const int tid = opq_tid(), wid = __builtin_amdgcn_readfirstlane(tid >> 6), lane = tid & 63, wr = wid >> 2, wc = wid & 3, fr = lane & 15, fq = lane >> 4;
    const int K = g.K, nt = K / BK;
    unsigned voffA[2], voffB[2];
#pragma unroll
    for (int i = 0; i < 2; ++i) { int R, C; stage_rc(tid * 16 + i * 8192, R, C); const int Rb = Epi::PERM ? ((R & ~31) + perm32(R & 31)) : R;
        voffA[i] = (unsigned)(R * K + C) * 2u; voffB[i] = (unsigned)(Rb * K + C) * 2u; }
    const size_t kstep = (size_t)(BK * 2);
    const size_t hstep = (size_t)HALF * K * 2;
    const size_t tstep = 2 * hstep;
    const unsigned ldsw = (unsigned)wid * 1024u;
    const int aoff = lds_byte(wr * 64 + fr, fq * 8), boff = lds_byte(wc * 32 + fr, fq * 8);
#define PG8_SA(b, h) (((b) * 2 + (h)) * HTB)
#define PG8_SB(b, h) ((4 + (b) * 2 + (h)) * HTB)
#define PG8_STAGE(bufoff, gbase, voff) do { _Pragma("unroll") for (int _i = 0; _i < 2; ++_i) \
        __builtin_amdgcn_global_load_lds((const unsigned*)((const char*)(gbase) + (voff)[_i]), (PG8_LAS unsigned*)(lds + (bufoff) + ldsw + _i * 8192), 16, 0, 0); } while (0)
#define PG8_LDA(dst, b, h) do { _Pragma("unroll") for (int m = 0; m < 4; ++m) _Pragma("unroll") for (int k = 0; k < 2; ++k) dst[m][k] = *(const PG8_LAS bf16x8*)(lds + PG8_SA(b, h) + aoff + m * 2048 + k * 1024); } while (0)
#define PG8_LDB(dst, b, h) do { _Pragma("unroll") for (int n = 0; n < 2; ++n) _Pragma("unroll") for (int k = 0; k < 2; ++k) dst[n][k] = *(const PG8_LAS bf16x8*)(lds + PG8_SB(b, h) + boff + n * 2048 + k * 1024); } while (0)
#define PG8_MMA(ai, bj, At, Bt) do { __builtin_amdgcn_s_setprio(1); _Pragma("unroll") for (int m = 0; m < 4; ++m) _Pragma("unroll") for (int n = 0; n < 2; ++n) _Pragma("unroll") for (int k = 0; k < 2; ++k) \
        acc[ai][bj][m][n] = __builtin_amdgcn_mfma_f32_16x16x32_bf16(Bt[n][k], At[m][k], acc[ai][bj][m][n], 0, 0, 0); __builtin_amdgcn_s_setprio(0); } while (0)
#define PG8_WAIT_V(n) asm volatile("s_waitcnt vmcnt(" #n ")" ::: "memory")
#define PG8_WAIT_L(n) asm volatile("s_waitcnt lgkmcnt(" #n ")" ::: "memory")
#define PG8_BAR __builtin_amdgcn_s_barrier()
#define PG8_SCHED __builtin_amdgcn_sched_barrier(0)
    Unit cur, nxt; int ui = 0;
    if (!S.next(0, cur)) return;
    f32x4 acc[2][2][4][2];
#pragma unroll
    for (int a = 0; a < 2; ++a)
#pragma unroll
        for (int b = 0; b < 2; ++b)
#pragma unroll
            for (int m = 0; m < 4; ++m)
#pragma unroll
                for (int n = 0; n < 2; ++n) acc[a][b][m][n] = (f32x4){0.f, 0.f, 0.f, 0.f};
    bf16x8 At[4][2], B0[2][2], B1[2][2];
    const char* cA = (const char*)g.A + (size_t)cur.pm * tstep; const char* cB = (const char*)g.Bt + (size_t)cur.pn * tstep;
    S.a_ready(cur);
    if constexpr (SP2) {
        PG8_STAGE(PG8_SB(0, 0), cB, voffB); PG8_STAGE(PG8_SB(0, 1), cB + hstep, voffB); PG8_STAGE(PG8_SA(0, 0), cA, voffA); PG8_STAGE(PG8_SA(0, 1), cA + hstep, voffA);
        if (wr == 1) PG8_BAR;
        PG8_WAIT_V(2); PG8_BAR;
        PG8_STAGE(PG8_SB(1, 0), cB + kstep, voffB); PG8_STAGE(PG8_SA(1, 0), cA + kstep, voffA); PG8_STAGE(PG8_SB(1, 1), cB + hstep + kstep, voffB);
        PG8_WAIT_V(6); PG8_BAR;
    } else {
        PG8_STAGE(PG8_SB(0, 0), cB, voffB); PG8_STAGE(PG8_SA(0, 0), cA, voffA); PG8_STAGE(PG8_SB(0, 1), cB + hstep, voffB); PG8_STAGE(PG8_SA(0, 1), cA + hstep, voffA);
        if (wr == 1) PG8_BAR;
        PG8_WAIT_V(4); PG8_BAR;
        PG8_STAGE(PG8_SB(1, 0), cB + kstep, voffB); PG8_STAGE(PG8_SA(1, 0), cA + kstep, voffA); PG8_STAGE(PG8_SB(1, 1), cB + hstep + kstep, voffB);
        PG8_WAIT_V(6); PG8_BAR;
    }
    for (;;) {
        const bool has_next = S.next(ui + 1, nxt);
        const char* nA = has_next ? (const char*)g.A + (size_t)nxt.pm * tstep : cA; const char* nB = has_next ? (const char*)g.Bt + (size_t)nxt.pn * tstep : cB;
        for (int t = 0; t < nt; t += 2) {
            const bool last = (t == nt - 2);
            const char* a1 = cA + (size_t)(t + 1) * kstep;
            const char* a2 = last ? nA : cA + (size_t)(t + 2) * kstep; const char* b2 = last ? nB : cB + (size_t)(t + 2) * kstep;
            const char* a3 = a2 + kstep; const char* b3 = b2 + kstep;
            if (last && has_next) S.a_ready(nxt);
            if constexpr (SP2) {
            PG8_LDB(B0, 0, 0); PG8_LDB(B1, 0, 1); PG8_SCHED; PG8_LDA(At, 0, 0); PG8_STAGE(PG8_SA(1, 1), a1 + hstep, voffA);
            PG8_WAIT_V(8); PG8_WAIT_L(0); PG8_BAR; PG8_MMA(0, 0, At, B0); PG8_MMA(0, 1, At, B1); PG8_BAR; PG8_SCHED;
            PG8_LDA(At, 0, 1); PG8_STAGE(PG8_SB(0, 0), b2, voffB); PG8_STAGE(PG8_SB(0, 1), b2 + hstep, voffB); PG8_STAGE(PG8_SA(0, 0), a2, voffA);
            PG8_WAIT_V(8); PG8_WAIT_L(0); PG8_BAR; PG8_MMA(1, 0, At, B0); PG8_MMA(1, 1, At, B1); PG8_BAR; PG8_SCHED;
            PG8_LDB(B0, 1, 0); PG8_LDB(B1, 1, 1); PG8_SCHED; PG8_LDA(At, 1, 0); PG8_STAGE(PG8_SA(0, 1), a2 + hstep, voffA);
            PG8_WAIT_V(8); PG8_WAIT_L(0); PG8_BAR; PG8_MMA(0, 0, At, B0); PG8_MMA(0, 1, At, B1); PG8_BAR; PG8_SCHED;
            PG8_LDA(At, 1, 1); PG8_STAGE(PG8_SB(1, 0), b3, voffB); PG8_STAGE(PG8_SB(1, 1), b3 + hstep, voffB); PG8_STAGE(PG8_SA(1, 0), a3, voffA);
            PG8_WAIT_V(8); PG8_WAIT_L(0); PG8_BAR; PG8_MMA(1, 0, At, B0); PG8_MMA(1, 1, At, B1); PG8_BAR; PG8_SCHED;
            } else {
            PG8_LDB(B0, 0, 0); PG8_SCHED; PG8_LDA(At, 0, 0); PG8_STAGE(PG8_SA(1, 1), a1 + hstep, voffA);
            PG8_WAIT_L(8); PG8_BAR; PG8_WAIT_L(0); PG8_MMA(0, 0, At, B0); PG8_BAR; PG8_SCHED;
            PG8_LDB(B1, 0, 1); PG8_STAGE(PG8_SB(0, 0), b2, voffB);
            PG8_BAR; PG8_WAIT_L(0); PG8_MMA(0, 1, At, B1); PG8_BAR;
            PG8_LDA(At, 0, 1); PG8_STAGE(PG8_SA(0, 0), a2, voffA);
            PG8_BAR; PG8_WAIT_L(0); PG8_MMA(1, 0, At, B0); PG8_BAR; PG8_SCHED;
            PG8_STAGE(PG8_SB(0, 1), b2 + hstep, voffB);
            PG8_WAIT_V(6); PG8_BAR; PG8_MMA(1, 1, At, B1); PG8_BAR;
            PG8_LDB(B0, 1, 0); PG8_SCHED; PG8_LDA(At, 1, 0); PG8_STAGE(PG8_SA(0, 1), a2 + hstep, voffA);
            PG8_WAIT_L(8); PG8_BAR; PG8_WAIT_L(0); PG8_MMA(0, 0, At, B0); PG8_BAR; PG8_SCHED;
            PG8_LDB(B1, 1, 1); PG8_STAGE(PG8_SB(1, 0), b3, voffB);
            PG8_BAR; PG8_WAIT_L(0); PG8_MMA(0, 1, At, B1); PG8_BAR;
            PG8_LDA(At, 1, 1); PG8_STAGE(PG8_SA(1, 0), a3, voffA);
            PG8_BAR; PG8_WAIT_L(0); PG8_MMA(1, 0, At, B0); PG8_BAR; PG8_SCHED;
            PG8_STAGE(PG8_SB(1, 1), b3 + hstep, voffB);
            PG8_WAIT_V(6); PG8_BAR; PG8_MMA(1, 1, At, B1); PG8_BAR;
            }
        }
        if constexpr (ALIGN_EPI) { if (wr == 0) PG8_BAR; }
        if constexpr (!Epi::AFTER_DRAIN) { E(acc, cur, wr, wc, fr, fq); S.done(cur); }
        if (!has_next) break;
#pragma unroll
        for (int a = 0; a < 2; ++a)
#pragma unroll
            for (int b = 0; b < 2; ++b)
#pragma unroll
                for (int m = 0; m < 4; ++m)
#pragma unroll
                    for (int n = 0; n < 2; ++n) acc[a][b][m][n] = (f32x4){0.f, 0.f, 0.f, 0.f};
        cur = nxt; cA = nA; cB = nB; ++ui;
        if constexpr (ALIGN_EPI) { if (wr == 1) PG8_BAR; }
    }
    PG8_WAIT_V(0);
    if constexpr (!ALIGN_EPI) { if (wr == 0) PG8_BAR; }
    PG8_BAR;
    if constexpr (Epi::AFTER_DRAIN) { E.fused(acc, cur, wr, wc, fr, fq, lds, wid, lane); S.done(cur); }
#undef PG8_SA
#undef PG8_SB
#undef PG8_STAGE
#undef PG8_LDA
#undef PG8_LDB
#undef PG8_MMA
#undef PG8_WAIT_V
#undef PG8_WAIT_L
#undef PG8_BAR
#undef PG8_SCHED
}
}

#define LAS __attribute__((address_space(3)))
using pg8::bf16_t; using pg8::bf16x8; using pg8::f32x4; using pg8::u32x4; using pg8::cvt_pk_bf16;
typedef short s16x4 __attribute__((ext_vector_type(4)));
typedef unsigned u32x2 __attribute__((ext_vector_type(2)));
typedef LAS s16x4 lds_s16x4;

constexpr int DM = 1024, NP = 16384, NS = 256, NR = NP + NS, FF = 4096, NPHASE = 12;
constexpr float EPS = 1e-6f;
constexpr int LDS_BYTES = 131072;
constexpr size_t MB = 1024 * 1024;
constexpr size_t WS_SS = 0;
constexpr size_t WS_WIN0 = 1 * MB, WS_WINKV1 = 3 * MB, WS_WOUT0 = 7 * MB, WS_WOUT1 = 9 * MB, WS_WMEM0 = 11 * MB, WS_WMEM1 = 13 * MB,
                 WS_WFF1_0 = 15 * MB, WS_WFF1_1 = 23 * MB, WS_WFF2_0 = 31 * MB, WS_WFF2_1 = 39 * MB, WS_WPOOL = 47 * MB;
constexpr size_t WS_XB = 48 * MB, WS_MEMB = 81 * MB, WS_R = 82 * MB, WS_Z = WS_R, WS_MIX = WS_R + 33 * MB, WS_HID = WS_R, WS_END = WS_R + 131 * MB;
constexpr size_t O_Y = 0, O_MEMK = 17039360, O_MEMV = 17563648, O_POOLP = 18087936, O_KP = 18103296, O_VP = 26491904, O_POOLS = 34880512, O_KS = 34941952, O_VS = 35073024;

struct Params { const float* in[23]; float* out; unsigned char* ws; int ph_lo, ph_hi; };

#define MFMA16(a, b, c) __builtin_amdgcn_mfma_f32_16x16x32_bf16((a), (b), (c), 0, 0, 0)
__device__ __forceinline__ void st_bf16x4(bf16_t* p, f32x4 v) { u32x2 w; w.x = cvt_pk_bf16(v[0], v[1]); w.y = cvt_pk_bf16(v[2], v[3]); *(u32x2*)p = w; }
__device__ __forceinline__ float wave_sum(float v) {
#pragma unroll
    for (int o = 1; o < 64; o <<= 1) v += __shfl_xor(v, o);
    return v;
}

typedef unsigned long long ss_t;
__device__ __forceinline__ ss_t ss_fix(float s) { return (ss_t)(s * 1048576.f + 0.5f); }
__device__ __forceinline__ float ss_rs(ss_t v) { return rsqrtf((float)v * (1.f / (1024.f * 1048576.f)) + EPS); }
struct FZ0 {
    static constexpr bool NEED_SS = false;
    const ss_t* ss; bf16_t* z; float* pool_p; float* pool_s;
    __device__ __forceinline__ float rowscale(int row) const { return ss_rs(ss[row]); }
    __device__ __forceinline__ float store(int row, int col, f32x4 v, float rs) const {
        v = v * rs; st_bf16x4(z + (size_t)row * DM + col, v);
        if (col < 512) {
            if (row < NP) { const int t = row & 8191; if (t >= 8177) *(f32x4*)(pool_p + (size_t)((row >> 13) * 15 + (t - 8177)) * 512 + col) = v; }
            else { const int r = row - NP, t = r & 31; if (t >= 17) *(f32x4*)(pool_s + (size_t)((r >> 5) * 15 + (t - 17)) * 512 + col) = v; }
        }
        return 0.f;
    }
    __device__ __forceinline__ void rowdone(int, float) const {}
};
struct FMemKV {
    static constexpr bool NEED_SS = false;
    const ss_t* ss; float* mk; float* mv;
    __device__ __forceinline__ float rowscale(int row) const { return ss_rs(ss[row]); }
    __device__ __forceinline__ float store(int row, int col, f32x4 v, float rs) const {
        v = v * rs; if (col < 512) *(f32x4*)(mk + (size_t)row * 512 + col) = v; else *(f32x4*)(mv + (size_t)row * 512 + (col - 512)) = v; return 0.f;
    }
    __device__ __forceinline__ void rowdone(int, float) const {}
};
struct FRes {
    static constexpr bool NEED_SS = true;
    const float* resid_p; const float* resid_s; float* xres; bf16_t* xb; ss_t* ss_out;
    __device__ __forceinline__ float rowscale(int) const { return 1.f; }
    __device__ __forceinline__ float store(int row, int col, f32x4 v, float) const {
        const float* rp = row < NP ? resid_p + (size_t)row * DM : resid_s + (size_t)(row - NP) * DM;
        const f32x4 x = *(const f32x4*)(rp + col) + v;
        *(f32x4*)(xres + (size_t)row * DM + col) = x;
        if (xb) st_bf16x4(xb + (size_t)row * DM + col, x);
        return (x[0] * x[0] + x[1] * x[1]) + (x[2] * x[2] + x[3] * x[3]);
    }
    __device__ __forceinline__ void rowdone(int row, float s) const { if (ss_out) atomicAdd(ss_out + row, ss_fix(s)); }
};
struct FFfn1 {
    static constexpr bool NEED_SS = false;
    const ss_t* ss; bf16_t* hid;
    __device__ __forceinline__ float rowscale(int row) const { return ss_rs(ss[row]); }
    __device__ __forceinline__ float store(int row, int col, f32x4 v, float rs) const {
        v = v * rs; v = __builtin_elementwise_max(v, (f32x4){0.f, 0.f, 0.f, 0.f}); v = v * v; st_bf16x4(hid + (size_t)row * FF + col, v); return 0.f;
    }
    __device__ __forceinline__ void rowdone(int, float) const {}
};
struct FZkv {
    static constexpr bool NEED_SS = false;
    const ss_t* ss; bf16_t* z; float* out;
    __device__ __forceinline__ float rowscale(int row) const { return ss_rs(ss[row]); }
    __device__ __forceinline__ float store(int row, int col, f32x4 v, float rs) const {
        v = v * rs;
        if (col < 1024) st_bf16x4(z + (size_t)row * DM + col, v);
        else { const int c = col - 1024; const bool smp = row >= NP, isv = c >= 512; const int r = smp ? row - NP : row;
            size_t off = smp ? (isv ? O_VS : O_KS) : (isv ? O_VP : O_KP); off += (size_t)r * 512 + (c & 511);
            *(f32x4*)(out + off) = v; }
        return 0.f;
    }
    __device__ __forceinline__ void rowdone(int, float) const {}
};

namespace pg8 {
template <class F> struct EpiF {
    static constexpr bool PERM = false, AFTER_DRAIN = false;
    F f;
    __device__ __forceinline__ void operator()(const f32x4 (&acc)[2][2][4][2], const Unit& u, int wr, int wc, int fr, int fq) const {
#pragma unroll
        for (int ai = 0; ai < 2; ++ai)
#pragma unroll
            for (int m = 0; m < 4; ++m) {
                const int row = u.pm * BM + ai * HALF + wr * 64 + m * 16 + fr;
                const float rs = f.rowscale(row); float ssq = 0.f;
#pragma unroll
                for (int bj = 0; bj < 2; ++bj)
#pragma unroll
                    for (int n = 0; n < 2; ++n) ssq += f.store(row, u.pn * BM + bj * HALF + wc * 32 + n * 16 + 4 * fq, acc[ai][bj][m][n], rs);
                if (F::NEED_SS) { ssq += __shfl_xor(ssq, 16); ssq += __shfl_xor(ssq, 32); if (fq == 0) f.rowdone(row, ssq); }
            }
    }
};
}

template <class F>
__device__ __forceinline__ void big_gemm(LAS unsigned char* lds, const bf16_t* A, const bf16_t* Bt, int N, int K, const F& f) {
    pg8::Gemm g{A, Bt, NP, N, K}; pg8::StaticOrder S; S.init(NP, N, (int)gridDim.x, (int)blockIdx.x);
    pg8::EpiF<F> E{f};
    pg8::gemm_phase<pg8::EpiF<F>, pg8::StaticOrder, true, true>(lds, g, S, E);
}

template <class F>
__device__ __forceinline__ void small_gemm(LAS unsigned char* lds, const bf16_t* A, const bf16_t* Bt, int K, int nrt, int nct, int row_base, const F& f) {
    const int tid = opq_tid(), wid = __builtin_amdgcn_readfirstlane(tid >> 6), lane = tid & 63, fr = lane & 15, fq = lane >> 4;
    const int kw = K >> 3;
    LAS f32x4* red = (LAS f32x4*)lds;
    for (int it = blockIdx.x; it < nrt * nct; it += gridDim.x) {
        const int rt = it % nrt, ct = it / nrt;
        const bf16_t* ap = A + (size_t)(rt * 32 + fr) * K + wid * kw + fq * 8;
        const bf16_t* bp = Bt + (size_t)(ct * 32 + fr) * K + wid * kw + fq * 8;
        f32x4 a00 = {0.f, 0.f, 0.f, 0.f}, a01 = a00, a10 = a00, a11 = a00;
#pragma unroll 4
        for (int k = 0; k < kw; k += 32) {
            const bf16x8 x0 = *(const bf16x8*)(ap + k), x1 = *(const bf16x8*)(ap + (size_t)16 * K + k);
            const bf16x8 y0 = *(const bf16x8*)(bp + k), y1 = *(const bf16x8*)(bp + (size_t)16 * K + k);
            a00 = MFMA16(y0, x0, a00); a01 = MFMA16(y1, x0, a01); a10 = MFMA16(y0, x1, a10); a11 = MFMA16(y1, x1, a11);
        }
        red[(wid * 4 + 0) * 64 + lane] = a00; red[(wid * 4 + 1) * 64 + lane] = a01; red[(wid * 4 + 2) * 64 + lane] = a10; red[(wid * 4 + 3) * 64 + lane] = a11;
        __syncthreads();
        if (tid < 256) {
            const int ij = tid >> 6; f32x4 s = red[ij * 64 + lane];
#pragma unroll
            for (int w = 1; w < 8; ++w) s = s + red[(w * 4 + ij) * 64 + lane];
            const int row = row_base + rt * 32 + (ij >> 1) * 16 + fr, col = ct * 32 + (ij & 1) * 16 + 4 * fq;
            const float rs = f.rowscale(row); const float q = f.store(row, col, s, rs);
            if (F::NEED_SS) f.rowdone(row, q);
        }
        __syncthreads();
    }
}

__device__ __forceinline__ void transpose_item(const float* W, int K, int N, const float* gk, const float* gn, bf16_t* WT, int row_off, LAS float* scr, int item, int lane) {
    const int nblk = N / 32, kb = item / nblk, nb = item % nblk, k0 = 64 * kb, n0 = 32 * nb;
    const float cn = gn ? gn[n0 + (lane & 31)] : 1.f;
#pragma unroll 8
    for (int i = 0; i < 32; ++i) { const int kk = 2 * i + (lane >> 5); float v = W[(size_t)(k0 + kk) * N + n0 + (lane & 31)] * cn; if (gk) v *= gk[k0 + kk]; scr[kk * 33 + (lane & 31)] = v; }
    asm volatile("s_waitcnt lgkmcnt(0)" ::: "memory");
    const int c = lane & 7;
#pragma unroll
    for (int j = 0; j < 4; ++j) { const int n = (lane >> 3) + 8 * j; const LAS float* s = scr + (8 * c) * 33 + n;
        u32x4 o; o.x = cvt_pk_bf16(s[0 * 33], s[1 * 33]); o.y = cvt_pk_bf16(s[2 * 33], s[3 * 33]); o.z = cvt_pk_bf16(s[4 * 33], s[5 * 33]); o.w = cvt_pk_bf16(s[6 * 33], s[7 * 33]);
        *(u32x4*)(WT + (size_t)(row_off + n0 + n) * K + k0 + 8 * c) = o; }
    asm volatile("s_waitcnt lgkmcnt(0)" ::: "memory");
}
__device__ __forceinline__ void row_to_bf16(const float* xrow, bf16_t* orow, ss_t* ss, int lane) {
    const f32x4* xr = (const f32x4*)xrow + lane; f32x4 v[4]; float s = 0.f;
#pragma unroll
    for (int j = 0; j < 4; ++j) { v[j] = xr[64 * j]; s += (v[j][0] * v[j][0] + v[j][1] * v[j][1]) + (v[j][2] * v[j][2] + v[j][3] * v[j][3]); }
    s = wave_sum(s);
#pragma unroll
    for (int j = 0; j < 4; ++j) st_bf16x4(orow + 4 * lane + 256 * j, v[j]);
    if (lane == 0) *ss = ss_fix(s);
}

constexpr int KV_STRIDE = 288, KV_TILE = 64 * KV_STRIDE;
struct AttnArgs {
    const bf16_t* q; bf16_t* o;
    const float* k0; const float* v0;
    const float* k1; const float* v1;
    int nq, nk0, nk, qpos0, lim_base; float slope_l2;
};
template <int NC>
__device__ __forceinline__ void attn_unit(LAS unsigned char* lds, const AttnArgs& a, float lam, float post, const float* g_sub) {
    const int tid = opq_tid(), wid = __builtin_amdgcn_readfirstlane(tid >> 6), lane = tid & 63, fr = lane & 15, fq = lane >> 4;
    const int ntiles = (a.nk + 63) >> 6, q0w = wid * 16;
    const bool active = q0w < a.nq;
    const int tile_lim = a.lim_base + (wid >> 2);
    bf16x8 qf[4];
#pragma unroll
    for (int ks = 0; ks < 4; ++ks) qf[ks] = (bf16x8){0, 0, 0, 0, 0, 0, 0, 0};
    if (active) {
        const bf16_t* qp = a.q + (size_t)(q0w + fr) * DM + fq * 8;
#pragma unroll
        for (int ks = 0; ks < 4; ++ks) qf[ks] = *(const bf16x8*)(qp + ks * 32);
    }
    f32x4 O[NC][8]; float mrun[NC], lrun[NC];
#pragma unroll
    for (int c = 0; c < NC; ++c) { mrun[c] = -1e30f; lrun[c] = 0.f;
#pragma unroll
        for (int dt = 0; dt < 8; ++dt) O[c][dt] = (f32x4){0.f, 0.f, 0.f, 0.f}; }
    f32x4 kr[4], vr[4];
    const int skey = tid >> 5, sc4 = tid & 31;
#define ATT_LOAD(kt_) do { _Pragma("unroll") for (int j = 0; j < 4; ++j) { const int gk = (kt_) * 64 + skey + 16 * j; \
        if (gk < a.nk) { const float* kp; const float* vp; if (gk < a.nk0) { kp = a.k0 + (size_t)gk * 512; vp = a.v0 + (size_t)gk * 512; } else { kp = a.k1 + (size_t)(gk - a.nk0) * 512; vp = a.v1 + (size_t)(gk - a.nk0) * 512; } \
            kr[j] = *(const f32x4*)(kp + 4 * sc4); vr[j] = *(const f32x4*)(vp + 4 * sc4); } \
        else { kr[j] = (f32x4){0.f, 0.f, 0.f, 0.f}; vr[j] = kr[j]; } } } while (0)
#define ATT_STORE(b_) do { LAS unsigned char* base_ = lds + (b_) * 2 * KV_TILE + sc4 * 8; _Pragma("unroll") for (int j = 0; j < 4; ++j) { \
        u32x2 w_; w_.x = cvt_pk_bf16(kr[j][0], kr[j][1]); w_.y = cvt_pk_bf16(kr[j][2], kr[j][3]); *(LAS u32x2*)(base_ + (skey + 16 * j) * KV_STRIDE) = w_; \
        w_.x = cvt_pk_bf16(vr[j][0], vr[j][1]); w_.y = cvt_pk_bf16(vr[j][2], vr[j][3]); *(LAS u32x2*)(base_ + KV_TILE + (skey + 16 * j) * KV_STRIDE) = w_; } } while (0)
    ATT_LOAD(0); ATT_STORE(0); __syncthreads();
    constexpr float SC = (NC == 2 ? 0.125f : 0.08838834764831845f) * 1.4426950408889634f;
    const int qpos = a.qpos0 + q0w + fr;
    for (int kt = 0; kt < ntiles; ++kt) {
        if (kt + 1 < ntiles) ATT_LOAD(kt + 1);
        if (active && kt <= tile_lim) {
            const LAS unsigned char* kb = lds + (kt & 1) * 2 * KV_TILE; const LAS unsigned char* vb = kb + KV_TILE;
            f32x4 S[NC][4];
#pragma unroll
            for (int c = 0; c < NC; ++c)
#pragma unroll
                for (int t = 0; t < 4; ++t) S[c][t] = (f32x4){0.f, 0.f, 0.f, 0.f};
#pragma unroll
            for (int t = 0; t < 4; ++t)
#pragma unroll
                for (int ks = 0; ks < 4; ++ks) { const bf16x8 kf = *(const LAS bf16x8*)(kb + (t * 16 + fr) * KV_STRIDE + ks * 64 + fq * 16);
                    const int c = (NC == 2) ? (ks >> 1) : 0; S[c][t] = MFMA16(kf, qf[ks], S[c][t]); }
            const bool tail = (kt * 64 + 64 > a.nk);
            float mx[NC];
#pragma unroll
            for (int c = 0; c < NC; ++c) mx[c] = -1e30f;
#pragma unroll
            for (int t = 0; t < 4; ++t)
#pragma unroll
                for (int i = 0; i < 4; ++i) { const int kpos = kt * 64 + t * 16 + 4 * fq + i;
                    float bias = 0.f; if (NC == 2) bias = a.slope_l2 * fabsf((float)(qpos - kpos));
#pragma unroll
                    for (int c = 0; c < NC; ++c) { float s = S[c][t][i] * SC - bias; if (tail && kpos >= a.nk) s = -1e30f; S[c][t][i] = s; mx[c] = fmaxf(mx[c], s); } }
            bf16x8 pf[NC][2];
#pragma unroll
            for (int c = 0; c < NC; ++c) {
                float m = mx[c]; m = fmaxf(m, __shfl_xor(m, 16)); m = fmaxf(m, __shfl_xor(m, 32));
                const float mn = fmaxf(mrun[c], m), alpha = exp2f(mrun[c] - mn); mrun[c] = mn;
                float ps = 0.f;
#pragma unroll
                for (int t = 0; t < 4; ++t)
#pragma unroll
                    for (int i = 0; i < 4; ++i) { const float p = exp2f(S[c][t][i] - mn); S[c][t][i] = p; ps += p; }
                lrun[c] = lrun[c] * alpha + ps;
#pragma unroll
                for (int dt = 0; dt < 8; ++dt) O[c][dt] = O[c][dt] * alpha;
#pragma unroll
                for (int s = 0; s < 2; ++s) { u32x4 w; w.x = cvt_pk_bf16(S[c][2 * s][0], S[c][2 * s][1]); w.y = cvt_pk_bf16(S[c][2 * s][2], S[c][2 * s][3]);
                    w.z = cvt_pk_bf16(S[c][2 * s + 1][0], S[c][2 * s + 1][1]); w.w = cvt_pk_bf16(S[c][2 * s + 1][2], S[c][2 * s + 1][3]); pf[c][s] = __builtin_bit_cast(bf16x8, w); }
            }
#pragma unroll
            for (int s = 0; s < 2; ++s)
#pragma unroll
                for (int dt = 0; dt < 8; ++dt) {
                    const LAS unsigned char* vp = vb + (32 * s + 4 * fq + (fr >> 2)) * KV_STRIDE + dt * 32 + 8 * (fr & 3);
                    const s16x4 lo = __builtin_amdgcn_ds_read_tr16_b64_v4i16((lds_s16x4*)vp), hi = __builtin_amdgcn_ds_read_tr16_b64_v4i16((lds_s16x4*)(vp + 16 * KV_STRIDE));
                    const bf16x8 vf = __builtin_shufflevector(lo, hi, 0, 1, 2, 3, 4, 5, 6, 7);
#pragma unroll
                    for (int c = 0; c < NC; ++c) O[c][dt] = MFMA16(vf, pf[c][s], O[c][dt]);
                }
        }
        if (kt + 1 < ntiles) ATT_STORE((kt + 1) & 1);
        __syncthreads();
    }
#undef ATT_LOAD
#undef ATT_STORE
    if (active) {
        float inv[NC];
#pragma unroll
        for (int c = 0; c < NC; ++c) { float l = lrun[c]; l += __shfl_xor(l, 16); l += __shfl_xor(l, 32); inv[c] = 1.f / l; }
        bf16_t* op = a.o + (size_t)(q0w + fr) * DM + 4 * fq;
        if (NC == 1) {
#pragma unroll
            for (int dt = 0; dt < 8; ++dt) st_bf16x4(op + dt * 16, O[0][dt] * inv[0]);
        } else {
            float ssq = 0.f; const float li = lam * inv[NC - 1];
#pragma unroll
            for (int dt = 0; dt < 8; ++dt) { const f32x4 o = O[0][dt] * inv[0] - O[NC - 1][dt] * li; O[0][dt] = o; ssq += (o[0] * o[0] + o[1] * o[1]) + (o[2] * o[2] + o[3] * o[3]); }
            ssq += __shfl_xor(ssq, 16); ssq += __shfl_xor(ssq, 32);
            const float r = rsqrtf(ssq * (1.f / 128.f) + EPS) * post;
#pragma unroll
            for (int dt = 0; dt < 8; ++dt) { const f32x4 g = *(const f32x4*)(g_sub + dt * 16 + 4 * fq); st_bf16x4(op + dt * 16, O[0][dt] * g * r); }
        }
    }
}

__device__ __forceinline__ void pool_unit(LAS unsigned char* lds, const bf16_t* z, int r0, int nrows, int t0, const float* hist, bool prompt, const bf16_t* WpT, bf16_t* mix) {
    const int tid = opq_tid(), wid = __builtin_amdgcn_readfirstlane(tid >> 6), lane = tid & 63, fr = lane & 15, fq = lane >> 4;
    for (int g = 0; g < 4; ++g) {
        for (int idx = tid; idx < (nrows + 15) * 16; idx += 512) {
            const int j = idx >> 4, c8 = idx & 15; bf16x8 val = (bf16x8){0, 0, 0, 0, 0, 0, 0, 0};
            if (j >= 15 || (hist == nullptr && t0 > 0)) val = *(const bf16x8*)(z + (size_t)(r0 - 15 + j) * DM + g * 128 + c8 * 8);
            else if (hist != nullptr) { const f32x4 h0 = *(const f32x4*)(hist + (size_t)j * 512 + g * 128 + c8 * 8), h1 = *(const f32x4*)(hist + (size_t)j * 512 + g * 128 + c8 * 8 + 4);
                u32x4 w; w.x = cvt_pk_bf16(h0[0], h0[1]); w.y = cvt_pk_bf16(h0[2], h0[3]); w.z = cvt_pk_bf16(h1[0], h1[1]); w.w = cvt_pk_bf16(h1[2], h1[3]); val = __builtin_bit_cast(bf16x8, w); }
            *(LAS bf16x8*)(lds + j * KV_STRIDE + c8 * 16) = val;
        }
        __syncthreads();
        if (wid * 16 < nrows) {
            const int win = 2 << g, jr = 15 + wid * 16 + fr, t = t0 + wid * 16 + fr;
            const float icnt = 1.f / (float)(prompt ? (t + 1 < win ? t + 1 : win) : win);
            bf16x8 af[4];
#pragma unroll
            for (int ks = 0; ks < 4; ++ks) {
                float sum[8], u[8];
#pragma unroll
                for (int e = 0; e < 8; ++e) sum[e] = 0.f;
                for (int i = 0; i < win; ++i) { const bf16x8 v = *(const LAS bf16x8*)(lds + (jr - i) * KV_STRIDE + ks * 64 + fq * 16);
#pragma unroll
                    for (int e = 0; e < 8; ++e) { const float f = __uint_as_float(((unsigned)(unsigned short)v[e]) << 16); sum[e] += f; if (i == 0) u[e] = f; } }
                u32x4 w; w.x = cvt_pk_bf16(sum[0] * icnt - u[0], sum[1] * icnt - u[1]); w.y = cvt_pk_bf16(sum[2] * icnt - u[2], sum[3] * icnt - u[3]);
                w.z = cvt_pk_bf16(sum[4] * icnt - u[4], sum[5] * icnt - u[5]); w.w = cvt_pk_bf16(sum[6] * icnt - u[6], sum[7] * icnt - u[7]); af[ks] = __builtin_bit_cast(bf16x8, w);
            }
            const bf16_t* wp = WpT + (size_t)g * 16384 + (size_t)fr * 128 + fq * 8;
            bf16_t* op = mix + (size_t)(r0 + wid * 16 + fr) * DM + g * 128 + 4 * fq;
#pragma unroll
            for (int nt = 0; nt < 8; ++nt) { f32x4 acc = {0.f, 0.f, 0.f, 0.f};
#pragma unroll
                for (int ks = 0; ks < 4; ++ks) { const bf16x8 bfv = *(const bf16x8*)(wp + nt * 16 * 128 + ks * 32); acc = MFMA16(bfv, af[ks], acc); }
                st_bf16x4(op + nt * 16, acc); }
        }
        __syncthreads();
    }
}

__global__ void __launch_bounds__(512, 2) yoco_fwd(Params p) {
    extern __shared__ __attribute__((aligned(16))) unsigned char lds_raw[];
    LAS unsigned char* lds = (LAS unsigned char*)lds_raw;
    const int tid = opq_tid(), wid = __builtin_amdgcn_readfirstlane(tid >> 6), lane = tid & 63;
    const int G = gridDim.x, gw = blockIdx.x * 8 + wid, NGW = G * 8;
    unsigned char* ws = p.ws; float* out = p.out;
    ss_t* ss0 = (ss_t*)(ws + WS_SS); ss_t* ss1 = ss0 + NR; ss_t* ss2 = ss1 + NR; ss_t* ss3 = ss2 + NR; ss_t* ssm = ss3 + NR;
    bf16_t* xb = (bf16_t*)(ws + WS_XB); bf16_t* memb = (bf16_t*)(ws + WS_MEMB); bf16_t* zb = (bf16_t*)(ws + WS_Z); bf16_t* mix = (bf16_t*)(ws + WS_MIX); bf16_t* hid = (bf16_t*)(ws + WS_HID);
    const float* x_prompt = p.in[0]; const float* x_sample = p.in[1];
    const int lo = p.ph_lo, hi = p.ph_hi;
#define IN(k) (lo <= (k) && (k) < hi)
#define SEAM(k) do { if (IN(k) && IN((k) + 1)) cg::this_grid().sync(); } while (0)

    if (IN(0)) {
        LAS float* scr = (LAS float*)(lds + wid * 8448);
        constexpr int I_SQ = 16 * 32, I_F1 = 16 * 128, I_F2 = 64 * 32, I_P = 2 * 4;
        constexpr int NITEMS = 7 * I_SQ + 2 * I_F1 + 2 * I_F2 + 4 * I_P;
        for (int it = gw; it < NITEMS; it += NGW) {
            int r = it;
            if (r < 7 * I_SQ) { const int m = r / I_SQ; r -= m * I_SQ;
                if (m == 0) transpose_item(p.in[9], DM, DM, p.in[8], nullptr, (bf16_t*)(ws + WS_WIN0), 0, scr, r, lane);
                else if (m == 1) transpose_item(p.in[9] + (size_t)DM * DM, DM, DM, p.in[8] + DM, nullptr, (bf16_t*)(ws + WS_WINKV1), 0, scr, r, lane);
                else if (m == 2) transpose_item(p.in[21], DM, DM, p.in[20], nullptr, (bf16_t*)(ws + WS_WINKV1), DM, scr, r, lane);
                else if (m == 3) transpose_item(p.in[10], DM, DM, nullptr, nullptr, (bf16_t*)(ws + WS_WOUT0), 0, scr, r, lane);
                else if (m == 4) transpose_item(p.in[10] + (size_t)DM * DM, DM, DM, nullptr, nullptr, (bf16_t*)(ws + WS_WOUT1), 0, scr, r, lane);
                else if (m == 5) transpose_item(p.in[12], DM, DM, p.in[11], nullptr, (bf16_t*)(ws + WS_WMEM0), 0, scr, r, lane);
                else transpose_item(p.in[12] + (size_t)DM * DM, DM, DM, p.in[11] + DM, nullptr, (bf16_t*)(ws + WS_WMEM1), 0, scr, r, lane);
                continue; }
            r -= 7 * I_SQ;
            if (r < 2 * I_F1) { const int l = r / I_F1; r -= l * I_F1; transpose_item(p.in[14] + (size_t)l * DM * FF, DM, FF, p.in[13] + l * DM, nullptr, (bf16_t*)(ws + (l ? WS_WFF1_1 : WS_WFF1_0)), 0, scr, r, lane); continue; }
            r -= 2 * I_F1;
            if (r < 2 * I_F2) { const int l = r / I_F2; r -= l * I_F2; transpose_item(p.in[15] + (size_t)l * FF * DM, FF, DM, nullptr, nullptr, (bf16_t*)(ws + (l ? WS_WFF2_1 : WS_WFF2_0)), 0, scr, r, lane); continue; }
            r -= 2 * I_F2;
            { const int g = r / I_P; r -= g * I_P; transpose_item(p.in[16] + (size_t)g * 16384, 128, 128, nullptr, p.in[17] + g * 128, (bf16_t*)(ws + WS_WPOOL) + (size_t)g * 16384, 0, scr, r, lane); }
        }
        for (int m = gw; m < NR; m += NGW) row_to_bf16(m < NP ? x_prompt + (size_t)m * DM : x_sample + (size_t)(m - NP) * DM, xb + (size_t)m * DM, ss0 + m, lane);
        for (int m = gw; m < 512; m += NGW) row_to_bf16(p.in[2] + (size_t)m * DM, memb + (size_t)m * DM, ssm + m, lane);
        for (int i = blockIdx.x * 512 + tid; i < 3 * NR; i += G * 512) ss1[i] = 0ull;
    }
    SEAM(0);
    if (IN(1)) {
        FZ0 f{ss0, zb, out + O_POOLP, out + O_POOLS};
        big_gemm(lds, xb, (const bf16_t*)(ws + WS_WIN0), DM, DM, f);
        small_gemm(lds, xb + (size_t)NP * DM, (const bf16_t*)(ws + WS_WIN0), DM, NS / 32, DM / 32, NP, f);
        for (int l = 0; l < 2; ++l) { FMemKV fm{ssm, out + O_MEMK + (size_t)l * 512 * 512, out + O_MEMV + (size_t)l * 512 * 512};
            small_gemm(lds, memb, (const bf16_t*)(ws + (l ? WS_WMEM1 : WS_WMEM0)), DM, 512 / 32, DM / 32, 0, fm); }
    }
    SEAM(1);
    for (int layer = 0; layer < 2; ++layer) {
        const int ph = layer ? 7 : 2;
        if (IN(ph)) {
            const float* memk_p = out + O_MEMK + (size_t)layer * 512 * 512; const float* memv_p = out + O_MEMV + (size_t)layer * 512 * 512;
            const float* memk_s = p.in[5] + (size_t)layer * 8 * 256 * 512; const float* memv_s = p.in[6] + (size_t)layer * 8 * 256 * 512;
            if (layer == 1) {
                const float* lq = p.in[18];
                const float d1 = wave_sum(lq[lane] * lq[64 + lane]), d2 = wave_sum(lq[128 + lane] * lq[192 + lane]);
                const float lam_i = 0.8f - 0.6f * expf(-0.3f), lam = expf(d1) - expf(d2) + lam_i;
                for (int pr = blockIdx.x; pr < 256; pr += G) {
                    const int bh = pr & 7, j = pr >> 3, b = bh >> 2, h = bh & 3;
                    for (int half = 0; half < 2; ++half) {
                        const int qb = half ? j : 63 - j; const size_t r0 = (size_t)b * 8192 + (size_t)qb * 128;
                        AttnArgs a; a.q = zb + r0 * DM + h * 128; a.o = mix + r0 * DM + h * 128;
                        a.k0 = out + O_KP + (size_t)b * 8192 * 512 + h * 128; a.v0 = out + O_VP + (size_t)b * 8192 * 512 + h * 128; a.k1 = a.k0; a.v1 = a.v0;
                        a.nq = 128; a.nk0 = a.nk = (2 * qb + 2) * 64; a.qpos0 = qb * 128; a.lim_base = 2 * qb; a.slope_l2 = exp2f(-2.f * (float)(h + 1)) * 1.4426950408889634f;
                        attn_unit<2>(lds, a, lam, 1.f - lam_i, p.in[19]);
                    }
                }
                for (int e = blockIdx.x; e < 32; e += G) {
                    const int b = e >> 2, h = e & 3; const size_t r0 = (size_t)NP + b * 32;
                    AttnArgs a; a.q = zb + r0 * DM + h * 128; a.o = mix + r0 * DM + h * 128;
                    a.k0 = p.in[3] + (size_t)b * 2048 * 512 + h * 128; a.v0 = p.in[4] + (size_t)b * 2048 * 512 + h * 128;
                    a.k1 = out + O_KS + (size_t)b * 32 * 512 + h * 128; a.v1 = out + O_VS + (size_t)b * 32 * 512 + h * 128;
                    a.nq = 32; a.nk0 = 2048; a.nk = 2080; a.qpos0 = 2048; a.lim_base = 1 << 20; a.slope_l2 = exp2f(-2.f * (float)(h + 1)) * 1.4426950408889634f;
                    attn_unit<2>(lds, a, lam, 1.f - lam_i, p.in[19]);
                }
            } else {
                for (int u = blockIdx.x; u < 136; u += G) {
                    if (u < 128) pool_unit(lds, zb, u * 128, 128, (u & 63) * 128, nullptr, true, (const bf16_t*)(ws + WS_WPOOL), mix);
                    else { const int b = u - 128; pool_unit(lds, zb, NP + b * 32, 32, 0, p.in[7] + (size_t)b * 15 * 512, false, (const bf16_t*)(ws + WS_WPOOL), mix); }
                }
            }
            for (int e = G - 1 - (int)blockIdx.x; e < 544; e += G) {
                AttnArgs a; a.qpos0 = 0; a.lim_base = 1 << 20; a.slope_l2 = 0.f; a.nk0 = a.nk = 256;
                if (e < 512) { const int tile = e >> 2, h = e & 3, b = tile >> 6; const size_t r0 = (size_t)tile * 128;
                    a.q = zb + r0 * DM + 512 + h * 128; a.o = mix + r0 * DM + 512 + h * 128; a.nq = 128;
                    a.k0 = memk_p + (size_t)b * 256 * 512 + h * 128; a.v0 = memv_p + (size_t)b * 256 * 512 + h * 128; }
                else { const int b = (e - 512) >> 2, h = e & 3; const size_t r0 = (size_t)NP + b * 32;
                    a.q = zb + r0 * DM + 512 + h * 128; a.o = mix + r0 * DM + 512 + h * 128; a.nq = 32;
                    a.k0 = memk_s + (size_t)b * 256 * 512 + h * 128; a.v0 = memv_s + (size_t)b * 256 * 512 + h * 128; }
                a.k1 = a.k0; a.v1 = a.v0;
                attn_unit<1>(lds, a, 0.f, 1.f, nullptr);
            }
        }
        SEAM(ph);
        if (IN(ph + 1)) {
            FRes f{layer ? out + O_Y : x_prompt, layer ? out + O_Y + (size_t)NP * DM : x_sample, out + O_Y, xb, layer ? ss3 : ss1};
            const bf16_t* W = (const bf16_t*)(ws + (layer ? WS_WOUT1 : WS_WOUT0));
            big_gemm(lds, mix, W, DM, DM, f);
            small_gemm(lds, mix + (size_t)NP * DM, W, DM, NS / 32, DM / 32, NP, f);
        }
        SEAM(ph + 1);
        if (IN(ph + 2)) {
            FFfn1 f{layer ? ss3 : ss1, hid};
            const bf16_t* W = (const bf16_t*)(ws + (layer ? WS_WFF1_1 : WS_WFF1_0));
            big_gemm(lds, xb, W, FF, DM, f);
            small_gemm(lds, xb + (size_t)NP * DM, W, DM, NS / 32, FF / 32, NP, f);
        }
        SEAM(ph + 2);
        if (IN(ph + 3)) {
            FRes f{out + O_Y, out + O_Y + (size_t)NP * DM, out + O_Y, layer ? nullptr : xb, layer ? nullptr : ss2};
            const bf16_t* W = (const bf16_t*)(ws + (layer ? WS_WFF2_1 : WS_WFF2_0));
            big_gemm(lds, hid, W, DM, FF, f);
            small_gemm(lds, hid + (size_t)NP * FF, W, FF, NS / 32, DM / 32, NP, f);
        }
        SEAM(ph + 3);
        if (layer == 0) {
            if (IN(6)) {
                FZkv f{ss2, zb, out};
                big_gemm(lds, xb, (const bf16_t*)(ws + WS_WINKV1), 2 * DM, DM, f);
                small_gemm(lds, xb + (size_t)NP * DM, (const bf16_t*)(ws + WS_WINKV1), DM, NS / 32, 2 * DM / 32, NP, f);
            }
            SEAM(6);
        }
    }
    if (IN(11)) {
        const float* gf = p.in[22];
        for (int m = gw; m < NR; m += NGW) {
            f32x4* xr = (f32x4*)(out + O_Y + (size_t)m * DM) + lane; f32x4 v[4]; float s = 0.f;
#pragma unroll
            for (int j = 0; j < 4; ++j) { v[j] = xr[64 * j]; s += (v[j][0] * v[j][0] + v[j][1] * v[j][1]) + (v[j][2] * v[j][2] + v[j][3] * v[j][3]); }
            const float r = rsqrtf(wave_sum(s) * (1.f / 1024.f) + EPS);
#pragma unroll
            for (int j = 0; j < 4; ++j) xr[64 * j] = v[j] * r * ((const f32x4*)gf)[lane + 64 * j];
        }
    }
#undef IN
#undef SEAM
}

extern "C" void kernel_launch(void* const* d_in, const int* in_sizes, int n_in, void* d_out, int out_size, void* d_ws, size_t ws_size, hipStream_t stream) {
    static int grid = 0;
    if (grid == 0) {
        int dev = 0, cus = 0, per_cu = 0;
        if (n_in != 23 || ws_size < WS_END) { fprintf(stderr, "kernel_launch: unexpected n_in %d / ws %zu\n", n_in, ws_size); grid = -1; return; }
        hipGetDevice(&dev); hipDeviceGetAttribute(&cus, hipDeviceAttributeMultiprocessorCount, dev);
        if (hipFuncSetAttribute((const void*)yoco_fwd, hipFuncAttributeMaxDynamicSharedMemorySize, LDS_BYTES) != hipSuccess) { fprintf(stderr, "kernel_launch: hipFuncSetAttribute failed\n"); grid = -1; return; }
        if (hipOccupancyMaxActiveBlocksPerMultiprocessor(&per_cu, (const void*)yoco_fwd, 512, LDS_BYTES) != hipSuccess || per_cu < 1) { fprintf(stderr, "kernel_launch: occupancy query says %d blocks per CU\n", per_cu); per_cu = 1; }
        (void)hipGetLastError();
        grid = cus;
    }
    if (grid < 0) return;
    Params p{};
    for (int i = 0; i < 23; ++i) p.in[i] = (const float*)d_in[i];
    p.out = (float*)d_out; p.ws = (unsigned char*)d_ws;
#if N_LAUNCHES == 1
    p.ph_lo = 0; p.ph_hi = NPHASE;
    void* args[] = {&p};
    hipError_t e = hipLaunchCooperativeKernel((const void*)yoco_fwd, dim3(grid), dim3(512), args, LDS_BYTES, stream);
    if (e != hipSuccess) fprintf(stderr, "cooperative launch failed: %s (grid %d)\n", hipGetErrorString(e), grid);
#else
    for (int ph = 0; ph < NPHASE; ++ph) { p.ph_lo = ph; p.ph_hi = ph + 1; hipLaunchKernelGGL(yoco_fwd, dim3(grid), dim3(512), LDS_BYTES, stream, p); }
#endif
}
```

```cpp
#include <hip/hip_runtime.h>
#include <hip/hip_cooperative_groups.h>
#include <cstdio>
#include <cstdint>
namespace cg = cooperative_groups;


__device__ __forceinline__ int opq_tid() { int t = threadIdx.x; asm volatile("" : "+v"(t)); return t; }
#ifndef REP2
#define REP2 1
#endif
#ifndef REP7
#define REP7 1
#endif
#ifndef REP0
#define REP0 1
#endif
#ifndef REP4
#define REP4 1
#endif
#ifndef REP7A
#define REP7A 1
#endif
#ifndef REP7B
#define REP7B 1
#endif
#ifndef REP7C
#define REP7C 1
#endif
#ifndef REPS
#define REPS 1
#endif
#ifndef REP1
#define REP1 1
#endif
#ifndef REP6
#define REP6 1
#endif
#ifndef N_LAUNCHES
#define N_LAUNCHES 1
#endif

namespace pg8 {
#define PG8_LAS __attribute__((address_space(3)))
typedef unsigned short bf16_t;
typedef short bf16x8 __attribute__((ext_vector_type(8)));
typedef float f32x4 __attribute__((ext_vector_type(4)));
typedef unsigned u32x4 __attribute__((ext_vector_type(4)));
constexpr int BM = 256, BK = 64, HALF = 128, HTB = HALF * BK * 2  , STAGE_BYTES = 8 * HTB, NXCD = 8, WGM = 8;

__host__ __device__ __forceinline__ int lds_byte(int r, int c) { const int st = (r >> 4) * 2 + (c >> 5), rr = r & 15, cc = c & 31, ob = rr * 64 + cc * 2; return st * 1024 + (ob ^ (((ob >> 9) & 1) << 5)); }
__host__ __device__ __forceinline__ void stage_rc(int b, int& R, int& C) { const int st = b / 1024, sb = b % 1024, swz = sb ^ (((sb >> 9) & 1) << 5); R = (st >> 1) * 16 + swz / 64; C = (st & 1) * 32 + (swz % 64) / 2; }
__host__ __device__ __forceinline__ int perm32(int rho) { const int n = rho >> 4, i = rho & 15; return 8 * (i >> 2) + 4 * n + (i & 3); }

struct Unit { int pm, pn; };
struct Gemm { const bf16_t* A; const bf16_t* Bt; int M, N, K; };

struct StaticOrder {
    int nM, nN, nwg, G, c;
    __host__ __device__ void init(int M, int N, int G_, int c_) { nM = M / BM; nN = N / BM; nwg = nM * nN; G = G_; c = c_; }
    __host__ __device__ bool next(int i, Unit& u) const {
        const long L = (long)i * G + c; if (L >= nwg) return false;
        int wgid = (int)L; { const int q = nwg / NXCD, r = nwg % NXCD, xcd = wgid % NXCD, off = wgid / NXCD; wgid = (xcd < r ? xcd * (q + 1) : r * (q + 1) + (xcd - r) * q) + off; }
        const int nig = WGM * nN, gid = wgid / nig, fm = gid * WGM, gsz = (nM - fm) < WGM ? (nM - fm) : WGM;
        u.pm = fm + ((wgid % nig) % gsz); u.pn = (wgid % nig) / gsz; return true;
    }
    __device__ __forceinline__ void a_ready(const Unit&) const {}
    __device__ __forceinline__ void done(const Unit&) const {}
};

typedef float f32x2 __attribute__((ext_vector_type(2)));
typedef __bf16 bf16x2v __attribute__((ext_vector_type(2)));
__device__ __forceinline__ unsigned cvt_pk_bf16(float lo, float hi) { const f32x2 f = {lo, hi}; return __builtin_bit_cast(unsigned, __builtin_convertvector(f, bf16x2v)); }
}
namespace pg8 {
template <class Epi, class Sched, bool ALIGN_EPI = false, bool SP2 = false>
__device__ __forceinline__ void gemm_phase(PG8_LAS unsigned char* lds, const Gemm g, const Sched& S, const Epi& E) {
    const int tid = opq_tid(), wid = __builtin_amdgcn_readfirstlane(tid >> 6), lane = tid & 63, wr = wid >> 2, wc = wid & 3, fr = lane & 15, fq = lane >> 4;
    const int K = g.K, nt = K / BK;
    unsigned voffA[2], voffB[2];
#pragma unroll
    for (int i = 0; i < 2; ++i) { int R, C; stage_rc(tid * 16 + i * 8192, R, C); const int Rb = Epi::PERM ? ((R & ~31) + perm32(R & 31)) : R;
        voffA[i] = (unsigned)(R * K + C) * 2u; voffB[i] = (unsigned)(Rb * K + C) * 2u; }
    const size_t kstep = (size_t)(BK * 2);
    const size_t hstep = (size_t)HALF * K * 2;
    const size_t tstep = 2 * hstep;
    const unsigned ldsw = (unsigned)wid * 1024u;
    const int aoff = lds_byte(wr * 64 + fr, fq * 8), boff = lds_byte(wc * 32 + fr, fq * 8);
#define PG8_SA(b, h) (((b) * 2 + (h)) * HTB)
#define PG8_SB(b, h) ((4 + (b) * 2 + (h)) * HTB)
#define PG8_STAGE(bufoff, gbase, voff) do { _Pragma("unroll") for (int _i = 0; _i < 2; ++_i) \
        __builtin_amdgcn_global_load_lds((const unsigned*)((const char*)(gbase) + (voff)[_i]), (PG8_LAS unsigned*)(lds + (bufoff) + ldsw + _i * 8192), 16, 0, 0); } while (0)
#define PG8_LDA(dst, b, h) do { _Pragma("unroll") for (int m = 0; m < 4; ++m) _Pragma("unroll") for (int k = 0; k < 2; ++k) dst[m][k] = *(const PG8_LAS bf16x8*)(lds + PG8_SA(b, h) + aoff + m * 2048 + k * 1024); } while (0)
#define PG8_LDB(dst, b, h) do { _Pragma("unroll") for (int n = 0; n < 2; ++n) _Pragma("unroll") for (int k = 0; k < 2; ++k) dst[n][k] = *(const PG8_LAS bf16x8*)(lds + PG8_SB(b, h) + boff + n * 2048 + k * 1024); } while (0)
#define PG8_MMA(ai, bj, At, Bt) do { __builtin_amdgcn_s_setprio(1); _Pragma("unroll") for (int m = 0; m < 4; ++m) _Pragma("unroll") for (int n = 0; n < 2; ++n) _Pragma("unroll") for (int k = 0; k < 2; ++k) \
        acc[ai][bj][m][n] = __builtin_amdgcn_mfma_f32_16x16x32_bf16(Bt[n][k], At[m][k], acc[ai][bj][m][n], 0, 0, 0); __builtin_amdgcn_s_setprio(0); } while (0)
#define PG8_WAIT_V(n) asm volatile("s_waitcnt vmcnt(" #n ")" ::: "memory")
#define PG8_WAIT_L(n) asm volatile("s_waitcnt lgkmcnt(" #n ")" ::: "memory")
#define PG8_BAR __builtin_amdgcn_s_barrier()
#define PG8_SCHED __builtin_amdgcn_sched_barrier(0)
    Unit cur, nxt; int ui = 0;
    if (!S.next(0, cur)) return;
    f32x4 acc[2][2][4][2];
#pragma unroll
    for (int a = 0; a < 2; ++a)
#pragma unroll
        for (int b = 0; b < 2; ++b)
#pragma unroll
            for (int m = 0; m < 4; ++m)
#pragma unroll
                for (int n = 0; n < 2; ++n) acc[a][b][m][n] = (f32x4){0.f, 0.f, 0.f, 0.f};
    bf16x8 At[4][2], B0[2][2], B1[2][2];
    const char* cA = (const char*)g.A + (size_t)cur.pm * tstep; const char* cB = (const char*)g.Bt + (size_t)cur.pn * tstep;
    S.a_ready(cur);
    if constexpr (SP2) {
        PG8_STAGE(PG8_SB(0, 0), cB, voffB); PG8_STAGE(PG8_SB(0, 1), cB + hstep, voffB); PG8_STAGE(PG8_SA(0, 0), cA, voffA); PG8_STAGE(PG8_SA(0, 1), cA + hstep, voffA);
        if (wr == 1) PG8_BAR;
        PG8_WAIT_V(2); PG8_BAR;
        PG8_STAGE(PG8_SB(1, 0), cB + kstep, voffB); PG8_STAGE(PG8_SA(1, 0), cA + kstep, voffA); PG8_STAGE(PG8_SB(1, 1), cB + hstep + kstep, voffB);
        PG8_WAIT_V(6); PG8_BAR;
    } else {
        PG8_STAGE(PG8_SB(0, 0), cB, voffB); PG8_STAGE(PG8_SA(0, 0), cA, voffA); PG8_STAGE(PG8_SB(0, 1), cB + hstep, voffB); PG8_STAGE(PG8_SA(0, 1), cA + hstep, voffA);
        if (wr == 1) PG8_BAR;
        PG8_WAIT_V(4); PG8_BAR;
        PG8_STAGE(PG8_SB(1, 0), cB + kstep, voffB); PG8_STAGE(PG8_SA(1, 0), cA + kstep, voffA); PG8_STAGE(PG8_SB(1, 1), cB + hstep + kstep, voffB);
        PG8_WAIT_V(6); PG8_BAR;
    }
    for (;;) {
        const bool has_next = S.next(ui + 1, nxt);
        const char* nA = has_next ? (const char*)g.A + (size_t)nxt.pm * tstep : cA; const char* nB = has_next ? (const char*)g.Bt + (size_t)nxt.pn * tstep : cB;
        for (int t = 0; t < nt; t += 2) {
            const bool last = (t == nt - 2);
            const char* a1 = cA + (size_t)(t + 1) * kstep;
            const char* a2 = last ? nA : cA + (size_t)(t + 2) * kstep; const char* b2 = last ? nB : cB + (size_t)(t + 2) * kstep;
            const char* a3 = a2 + kstep; const char* b3 = b2 + kstep;
            if (last && has_next) S.a_ready(nxt);
            if constexpr (SP2) {
            PG8_LDB(B0, 0, 0); PG8_LDB(B1, 0, 1); PG8_SCHED; PG8_LDA(At, 0, 0); PG8_STAGE(PG8_SA(1, 1), a1 + hstep, voffA);
            PG8_WAIT_V(8); PG8_WAIT_L(0); PG8_BAR; PG8_MMA(0, 0, At, B0); PG8_MMA(0, 1, At, B1); PG8_BAR; PG8_SCHED;
            PG8_LDA(At, 0, 1); PG8_STAGE(PG8_SB(0, 0), b2, voffB); PG8_STAGE(PG8_SB(0, 1), b2 + hstep, voffB); PG8_STAGE(PG8_SA(0, 0), a2, voffA);
            PG8_WAIT_V(8); PG8_WAIT_L(0); PG8_BAR; PG8_MMA(1, 0, At, B0); PG8_MMA(1, 1, At, B1); PG8_BAR; PG8_SCHED;
            PG8_LDB(B0, 1, 0); PG8_LDB(B1, 1, 1); PG8_SCHED; PG8_LDA(At, 1, 0); PG8_STAGE(PG8_SA(0, 1), a2 + hstep, voffA);
            PG8_WAIT_V(8); PG8_WAIT_L(0); PG8_BAR; PG8_MMA(0, 0, At, B0); PG8_MMA(0, 1, At, B1); PG8_BAR; PG8_SCHED;
            PG8_LDA(At, 1, 1); PG8_STAGE(PG8_SB(1, 0), b3, voffB); PG8_STAGE(PG8_SB(1, 1), b3 + hstep, voffB); PG8_STAGE(PG8_SA(1, 0), a3, voffA);
            PG8_WAIT_V(8); PG8_WAIT_L(0); PG8_BAR; PG8_MMA(1, 0, At, B0); PG8_MMA(1, 1, At, B1); PG8_BAR; PG8_SCHED;
            } else {
            PG8_LDB(B0, 0, 0); PG8_SCHED; PG8_LDA(At, 0, 0); PG8_STAGE(PG8_SA(1, 1), a1 + hstep, voffA);
            PG8_WAIT_L(8); PG8_BAR; PG8_WAIT_L(0); PG8_MMA(0, 0, At, B0); PG8_BAR; PG8_SCHED;
            PG8_LDB(B1, 0, 1); PG8_STAGE(PG8_SB(0, 0), b2, voffB);
            PG8_BAR; PG8_WAIT_L(0); PG8_MMA(0, 1, At, B1); PG8_BAR;
            PG8_LDA(At, 0, 1); PG8_STAGE(PG8_SA(0, 0), a2, voffA);
            PG8_BAR; PG8_WAIT_L(0); PG8_MMA(1, 0, At, B0); PG8_BAR; PG8_SCHED;
            PG8_STAGE(PG8_SB(0, 1), b2 + hstep, voffB);
            PG8_WAIT_V(6); PG8_BAR; PG8_MMA(1, 1, At, B1); PG8_BAR;
            PG8_LDB(B0, 1, 0); PG8_SCHED; PG8_LDA(At, 1, 0); PG8_STAGE(PG8_SA(0, 1), a2 + hstep, voffA);
            PG8_WAIT_L(8); PG8_BAR; PG8_WAIT_L(0); PG8_MMA(0, 0, At, B0); PG8_BAR; PG8_SCHED;
            PG8_LDB(B1, 1, 1); PG8_STAGE(PG8_SB(1, 0), b3, voffB);
            PG8_BAR; PG8_WAIT_L(0); PG8_MMA(0, 1, At, B1); PG8_BAR;
            PG8_LDA(At, 1, 1); PG8_STAGE(PG8_SA(1, 0), a3, voffA);
            PG8_BAR; PG8_WAIT_L(0); PG8_MMA(1, 0, At, B0); PG8_BAR; PG8_SCHED;
            PG8_STAGE(PG8_SB(1, 1), b3 + hstep, voffB);
            PG8_WAIT_V(6); PG8_BAR; PG8_MMA(1, 1, At, B1); PG8_BAR;
            }
        }
        if constexpr (ALIGN_EPI) { if (wr == 0) PG8_BAR; }
        if constexpr (!Epi::AFTER_DRAIN) { E(acc, cur, wr, wc, fr, fq); S.done(cur); }
        if (!has_next) break;
#pragma unroll
        for (int a = 0; a < 2; ++a)
#pragma unroll
            for (int b = 0; b < 2; ++b)
#pragma unroll
                for (int m = 0; m < 4; ++m)
#pragma unroll
                    for (int n = 0; n < 2; ++n) acc[a][b][m][n] = (f32x4){0.f, 0.f, 0.f, 0.f};
        cur = nxt; cA = nA; cB = nB; ++ui;
        if constexpr (ALIGN_EPI) { if (wr == 1) PG8_BAR; }
    }
    PG8_WAIT_V(0);
    if constexpr (!ALIGN_EPI) { if (wr == 0) PG8_BAR; }
    PG8_BAR;
    if constexpr (Epi::AFTER_DRAIN) { E.fused(acc, cur, wr, wc, fr, fq, lds, wid, lane); S.done(cur); }
#undef PG8_SA
#undef PG8_SB
#undef PG8_STAGE
#undef PG8_LDA
#undef PG8_LDB
#undef PG8_MMA
#undef PG8_WAIT_V
#undef PG8_WAIT_L
#undef PG8_BAR
#undef PG8_SCHED
}
}

#define LAS __attribute__((address_space(3)))
using pg8::bf16_t; using pg8::bf16x8; using pg8::f32x4; using pg8::u32x4; using pg8::cvt_pk_bf16;
typedef short s16x4 __attribute__((ext_vector_type(4)));
typedef unsigned u32x2 __attribute__((ext_vector_type(2)));
typedef LAS s16x4 lds_s16x4;

constexpr int DM = 1024, NP = 16384, NS = 256, NR = NP + NS, FF = 4096, NPHASE = 12;
constexpr float EPS = 1e-6f;
constexpr int LDS_BYTES = 131072 + 256 + 1024;
constexpr size_t MB = 1024 * 1024;
constexpr size_t WS_BAR = 768 * 1024;
constexpr size_t WS_Q = 768 * 1024 + 16384;
constexpr size_t WS_SS = 0;
constexpr size_t WS_WIN0 = 1 * MB, WS_WINKV1 = 3 * MB, WS_WOUT0 = 7 * MB, WS_WOUT1 = 9 * MB, WS_WMEM0 = 11 * MB, WS_WMEM1 = 13 * MB,
                 WS_WFF1_0 = 15 * MB, WS_WFF1_1 = 23 * MB, WS_WFF2_0 = 31 * MB, WS_WFF2_1 = 39 * MB, WS_WPOOL = 47 * MB;
constexpr size_t WS_XB = 48 * MB, WS_MEMB = 81 * MB, WS_R = 82 * MB, WS_Z = WS_R, WS_MIX = WS_R + 33 * MB, WS_HID = WS_R, WS_KB = WS_R + 66 * MB, WS_VB = WS_R + 83 * MB, WS_END = WS_R + 131 * MB;
constexpr size_t O_Y = 0, O_MEMK = 17039360, O_MEMV = 17563648, O_POOLP = 18087936, O_KP = 18103296, O_VP = 26491904, O_POOLS = 34880512, O_KS = 34941952, O_VS = 35073024;

constexpr size_t SKB_ROWS = 2112;
constexpr size_t Y_SKB = 0, Y_SVB = Y_SKB + 8 * SKB_ROWS * 512, Y_MKB = Y_SVB + 8 * SKB_ROWS * 512, Y_MVB = Y_MKB + 2 * 10 * 256 * 512, Y_END = Y_MVB + 2 * 10 * 256 * 512;
static_assert(Y_END * 2 <= (size_t)NP * DM * 4, "scratch must fit the y_prompt region");
struct Params { const float* in[23]; float* out; unsigned char* ws; int ph_lo, ph_hi; };

#define MFMA16(a, b, c) __builtin_amdgcn_mfma_f32_16x16x32_bf16((a), (b), (c), 0, 0, 0)
__device__ __forceinline__ void st_bf16x4(bf16_t* p, f32x4 v) { u32x2 w; w.x = cvt_pk_bf16(v[0], v[1]); w.y = cvt_pk_bf16(v[2], v[3]); *(u32x2*)p = w; }
__device__ __forceinline__ float wave_sum(float v) {
#pragma unroll
    for (int o = 1; o < 64; o <<= 1) v += __shfl_xor(v, o);
    return v;
}

typedef unsigned long long ss_t;
__device__ __forceinline__ ss_t ss_fix(float s) { return (ss_t)(s * 1048576.f + 0.5f); }
__device__ __forceinline__ float ss_rs(ss_t v) { return rsqrtf((float)v * (1.f / (1024.f * 1048576.f)) + EPS); }
struct FZ0 {
    static constexpr bool NEED_SS = false, HAS_PRE = false;
    const ss_t* ss; bf16_t* z; float* pool_p; float* pool_s; const LAS float* rst;
    __device__ __forceinline__ float rowscale(int row) const { return ss_rs(ss[row]); }
    __device__ __forceinline__ float store(int row, int col, f32x4 v, float rs) const {
        v = v * rs; st_bf16x4(z + (size_t)row * DM + col, col < 512 ? v : v * (0.08838834764831845f * 1.4426950408889634f));
        if (col < 512) {
            if (row < NP) { const int t = row & 8191; if (t >= 8177) *(f32x4*)(pool_p + (size_t)((row >> 13) * 15 + (t - 8177)) * 512 + col) = v; }
            else { const int r = row - NP, t = r & 31; if (t >= 17) *(f32x4*)(pool_s + (size_t)((r >> 5) * 15 + (t - 17)) * 512 + col) = v; }
        }
        return 0.f;
    }
    __device__ __forceinline__ float store8(int row, int col, f32x4 v0, f32x4 v1, float rs) const {
        v0 = v0 * rs; v1 = v1 * rs;
        if (col < 512) {
            if (row < NP) { const int t = row & 8191; if (t >= 8177) { float* pp = pool_p + (size_t)((row >> 13) * 15 + (t - 8177)) * 512 + col; *(f32x4*)pp = v0; *(f32x4*)(pp + 4) = v1; } }
        } else { v0 = v0 * (0.08838834764831845f * 1.4426950408889634f); v1 = v1 * (0.08838834764831845f * 1.4426950408889634f); }
        u32x4 w; w.x = cvt_pk_bf16(v0[0], v0[1]); w.y = cvt_pk_bf16(v0[2], v0[3]); w.z = cvt_pk_bf16(v1[0], v1[1]); w.w = cvt_pk_bf16(v1[2], v1[3]);
        *(u32x4*)(z + (size_t)row * DM + col) = w; return 0.f;
    }
    __device__ __forceinline__ void rowdone(int, float) const {}
};
struct FMemKV {
    static constexpr bool NEED_SS = false, HAS_PRE = false;
    const ss_t* ss; float* mk; float* mv; bf16_t* mkb; bf16_t* mvb;
    __device__ __forceinline__ float rowscale(int row) const { return ss_rs(ss[row]); }
    __device__ __forceinline__ float store(int row, int col, f32x4 v, float rs) const {
        v = v * rs; const int l = col >> 10, c = col & 1023; const size_t fo = (size_t)l * 512 * 512 + (size_t)row * 512, bo = (size_t)l * 10 * 256 * 512 + (size_t)row * 512;
        if (c < 512) { *(f32x4*)(mk + fo + c) = v; st_bf16x4(mkb + bo + c, v); } else { *(f32x4*)(mv + fo + (c - 512)) = v; st_bf16x4(mvb + bo + (c - 512), v); } return 0.f;
    }
    __device__ __forceinline__ void rowdone(int, float) const {}
};
struct FRes {
    static constexpr bool NEED_SS = true, HAS_PRE = true;
    float* xres; bf16_t* xb_in; bf16_t* xb; ss_t* ss_out; const LAS float* rst;
    __device__ __forceinline__ float rowscale(int) const { return 1.f; }
    __device__ __forceinline__ float store(int row, int col, f32x4 v, float) const {
        const u32x2 w = *(const u32x2*)(xb_in + (size_t)row * DM + col);
        const f32x4 x = (f32x4){__uint_as_float(w.x << 16), __uint_as_float(w.x & 0xffff0000u), __uint_as_float(w.y << 16), __uint_as_float(w.y & 0xffff0000u)} + v;
        if (xres) *(f32x4*)(xres + (size_t)row * DM + col) = x;
        if (xb) st_bf16x4(xb + (size_t)row * DM + col, x);
        return (x[0] * x[0] + x[1] * x[1]) + (x[2] * x[2] + x[3] * x[3]);
    }
    __device__ __forceinline__ u32x4 pre8(int row, int col) const { return *(const u32x4*)(xb_in + (size_t)row * DM + col); }
    __device__ __forceinline__ float fin8(int row, int col, f32x4 v0, f32x4 v1, u32x4 w) const {
        const f32x4 x0 = (f32x4){__uint_as_float(w.x << 16), __uint_as_float(w.x & 0xffff0000u), __uint_as_float(w.y << 16), __uint_as_float(w.y & 0xffff0000u)} + v0;
        const f32x4 x1 = (f32x4){__uint_as_float(w.z << 16), __uint_as_float(w.z & 0xffff0000u), __uint_as_float(w.w << 16), __uint_as_float(w.w & 0xffff0000u)} + v1;
        if (xres) { float* xp = xres + (size_t)row * DM + col; *(f32x4*)xp = x0; *(f32x4*)(xp + 4) = x1; }
        if (xb) { u32x4 o; o.x = cvt_pk_bf16(x0[0], x0[1]); o.y = cvt_pk_bf16(x0[2], x0[3]); o.z = cvt_pk_bf16(x1[0], x1[1]); o.w = cvt_pk_bf16(x1[2], x1[3]); *(u32x4*)(xb + (size_t)row * DM + col) = o; }
        return ((x0[0] * x0[0] + x0[1] * x0[1]) + (x0[2] * x0[2] + x0[3] * x0[3])) + ((x1[0] * x1[0] + x1[1] * x1[1]) + (x1[2] * x1[2] + x1[3] * x1[3]));
    }
    __device__ __forceinline__ void rowdone(int row, float s) const { if (ss_out) atomicAdd(ss_out + row, ss_fix(s)); }
};
struct FFfn1 {
    static constexpr bool NEED_SS = false, HAS_PRE = false;
    const ss_t* ss; bf16_t* hid; const LAS float* rst;
    __device__ __forceinline__ float rowscale(int row) const { return ss_rs(ss[row]); }
    __device__ __forceinline__ float store(int row, int col, f32x4 v, float rs) const {
        v = v * rs; v = __builtin_elementwise_max(v, (f32x4){0.f, 0.f, 0.f, 0.f}); v = v * v; st_bf16x4(hid + (size_t)row * FF + col, v); return 0.f;
    }
    __device__ __forceinline__ float store8(int row, int col, f32x4 v0, f32x4 v1, float rs) const {
        const f32x4 zz = {0.f, 0.f, 0.f, 0.f}; v0 = __builtin_elementwise_max(v0 * rs, zz); v1 = __builtin_elementwise_max(v1 * rs, zz); v0 = v0 * v0; v1 = v1 * v1;
        u32x4 w; w.x = cvt_pk_bf16(v0[0], v0[1]); w.y = cvt_pk_bf16(v0[2], v0[3]); w.z = cvt_pk_bf16(v1[0], v1[1]); w.w = cvt_pk_bf16(v1[2], v1[3]);
        *(u32x4*)(hid + (size_t)row * FF + col) = w; return 0.f;
    }
    __device__ __forceinline__ void rowdone(int, float) const {}
};
struct FZkv {
    static constexpr bool NEED_SS = false, HAS_PRE = false;
    const ss_t* ss; bf16_t* z; float* out; bf16_t* kb; bf16_t* vb; bf16_t* skb; bf16_t* svb; const LAS float* rst;
    __device__ __forceinline__ float rowscale(int row) const { return ss_rs(ss[row]); }
    __device__ __forceinline__ float store(int row, int col, f32x4 v, float rs) const {
        v = v * rs;
        if (col < 1024) st_bf16x4(z + (size_t)row * DM + col, v * (col < 512 ? (0.125f * 1.4426950408889634f) : (0.08838834764831845f * 1.4426950408889634f)));
        else { const int c = col - 1024; const bool smp = row >= NP, isv = c >= 512; const int r = smp ? row - NP : row;
            size_t off = smp ? (isv ? O_VS : O_KS) : (isv ? O_VP : O_KP); off += (size_t)r * 512 + (c & 511);
            *(f32x4*)(out + off) = v;
            if (!smp) st_bf16x4((isv ? vb : kb) + (size_t)r * 512 + (c & 511), v);
            else st_bf16x4((isv ? svb : skb) + ((size_t)(r >> 5) * SKB_ROWS + 2048 + (r & 31)) * 512 + (c & 511), v); }
        return 0.f;
    }
    __device__ __forceinline__ float store8(int row, int col, f32x4 v0, f32x4 v1, float rs) const {
        v0 = v0 * rs; v1 = v1 * rs;
        if (col < 1024) { const float sc = col < 512 ? (0.125f * 1.4426950408889634f) : (0.08838834764831845f * 1.4426950408889634f); v0 = v0 * sc; v1 = v1 * sc;
            u32x4 w; w.x = cvt_pk_bf16(v0[0], v0[1]); w.y = cvt_pk_bf16(v0[2], v0[3]); w.z = cvt_pk_bf16(v1[0], v1[1]); w.w = cvt_pk_bf16(v1[2], v1[3]); *(u32x4*)(z + (size_t)row * DM + col) = w; }
        else { const int c = col - 1024; const bool isv = c >= 512; float* op = out + (isv ? O_VP : O_KP) + (size_t)row * 512 + (c & 511); *(f32x4*)op = v0; *(f32x4*)(op + 4) = v1;
            u32x4 w; w.x = cvt_pk_bf16(v0[0], v0[1]); w.y = cvt_pk_bf16(v0[2], v0[3]); w.z = cvt_pk_bf16(v1[0], v1[1]); w.w = cvt_pk_bf16(v1[2], v1[3]); *(u32x4*)((isv ? vb : kb) + (size_t)row * 512 + (c & 511)) = w; }
        return 0.f;
    }
    __device__ __forceinline__ void rowdone(int, float) const {}
};

namespace pg8 {
template <class F> struct EpiF {
    static constexpr bool PERM = false, AFTER_DRAIN = false;
    F f;
    __device__ __forceinline__ void operator()(const f32x4 (&acc)[2][2][4][2], const Unit& u, int wr, int wc, int fr, int fq) const {
#pragma unroll
        for (int ai = 0; ai < 2; ++ai)
#pragma unroll
            for (int m = 0; m < 4; ++m) {
                const int row = u.pm * BM + ai * HALF + wr * 64 + m * 16 + fr;
                const float rs = f.rowscale(row); float ssq = 0.f;
#pragma unroll
                for (int bj = 0; bj < 2; ++bj)
#pragma unroll
                    for (int n = 0; n < 2; ++n) ssq += f.store(row, u.pn * BM + bj * HALF + wc * 32 + n * 16 + 4 * fq, acc[ai][bj][m][n], rs);
                if (F::NEED_SS) { ssq += __shfl_xor(ssq, 16); ssq += __shfl_xor(ssq, 32); if (fq == 0) f.rowdone(row, ssq); }
            }
    }
};
template <class F> struct EpiF8 {
    static constexpr bool PERM = true, AFTER_DRAIN = false;
    F f;
    __device__ __forceinline__ void operator()(const f32x4 (&acc)[2][2][4][2], const Unit& u, int wr, int wc, int fr, int fq) const {
        float rsv[2][4];
#pragma unroll
        for (int ai = 0; ai < 2; ++ai)
#pragma unroll
            for (int m = 0; m < 4; ++m) rsv[ai][m] = f.rst ? f.rst[ai * HALF + wr * 64 + m * 16 + fr] : f.rowscale(u.pm * BM + ai * HALF + wr * 64 + m * 16 + fr);
#pragma unroll
        for (int ai = 0; ai < 2; ++ai) {
            u32x4 pre[4][2];
#pragma unroll
            for (int m = 0; m < 4; ++m)
#pragma unroll
                for (int bj = 0; bj < 2; ++bj) { if constexpr (F::HAS_PRE) pre[m][bj] = f.pre8(u.pm * BM + ai * HALF + wr * 64 + m * 16 + fr, u.pn * BM + bj * HALF + wc * 32 + 8 * fq); else pre[m][bj] = (u32x4){0u, 0u, 0u, 0u}; }
            __builtin_amdgcn_sched_barrier(0);
#pragma unroll
            for (int m = 0; m < 4; ++m) {
                const int row = u.pm * BM + ai * HALF + wr * 64 + m * 16 + fr;
                float ssq = 0.f;
#pragma unroll
                for (int bj = 0; bj < 2; ++bj) { const int col = u.pn * BM + bj * HALF + wc * 32 + 8 * fq;
                    if constexpr (F::HAS_PRE) ssq += f.fin8(row, col, acc[ai][bj][m][0], acc[ai][bj][m][1], pre[m][bj]);
                    else ssq += f.store8(row, col, acc[ai][bj][m][0], acc[ai][bj][m][1], rsv[ai][m]); }
                if (F::NEED_SS) { ssq += __shfl_xor(ssq, 16); ssq += __shfl_xor(ssq, 32); if (fq == 0) f.rowdone(row, ssq); }
            }
        }
    }
};
struct EpiFinal {
    static constexpr bool PERM = true, AFTER_DRAIN = true;
    const bf16_t* xb; float* y; const float* g; ss_t* ss; unsigned* cnt;
    __device__ __forceinline__ void fused(f32x4 (&acc)[2][2][4][2], const Unit& u, int wr, int wc, int fr, int fq, PG8_LAS unsigned char*, int, int) const {
#pragma unroll
        for (int ai = 0; ai < 2; ++ai) {
            u32x2 pre[4][2][2];
#pragma unroll
            for (int m = 0; m < 4; ++m)
#pragma unroll
                for (int bj = 0; bj < 2; ++bj)
#pragma unroll
                    for (int n = 0; n < 2; ++n) pre[m][bj][n] = *(const u32x2*)(xb + (size_t)(u.pm * BM + ai * HALF + wr * 64 + m * 16 + fr) * DM + u.pn * BM + bj * HALF + wc * 32 + 8 * fq + 4 * n);
            __builtin_amdgcn_sched_barrier(0);
#pragma unroll
            for (int m = 0; m < 4; ++m) {
                const int row = u.pm * BM + ai * HALF + wr * 64 + m * 16 + fr; float ssq = 0.f;
#pragma unroll
                for (int bj = 0; bj < 2; ++bj)
#pragma unroll
                    for (int n = 0; n < 2; ++n) { const int col = u.pn * BM + bj * HALF + wc * 32 + 8 * fq + 4 * n;
                        const u32x2 w = pre[m][bj][n];
                        const f32x4 x = (f32x4){__uint_as_float(w.x << 16), __uint_as_float(w.x & 0xffff0000u), __uint_as_float(w.y << 16), __uint_as_float(w.y & 0xffff0000u)} + acc[ai][bj][m][n];
                        acc[ai][bj][m][n] = x; ssq += (x[0] * x[0] + x[1] * x[1]) + (x[2] * x[2] + x[3] * x[3]); }
                ssq += __shfl_xor(ssq, 16); ssq += __shfl_xor(ssq, 32);
                if (fq == 0) atomicAdd(ss + row, ss_fix(ssq));
            }
        }
        asm volatile("s_waitcnt vmcnt(0)" ::: "memory");
        __syncthreads();
        if (threadIdx.x == 0) {
            __hip_atomic_fetch_add(cnt + 64 * u.pm, 1u, __ATOMIC_RELAXED, __HIP_MEMORY_SCOPE_AGENT);
            while (__hip_atomic_load(cnt + 64 * u.pm, __ATOMIC_RELAXED, __HIP_MEMORY_SCOPE_AGENT) < 4u) __builtin_amdgcn_s_sleep(2);
        }
        __syncthreads();
        ss_t tot[2][4]; f32x4 gv[2][2];
#pragma unroll
        for (int ai = 0; ai < 2; ++ai)
#pragma unroll
            for (int m = 0; m < 4; ++m) tot[ai][m] = __hip_atomic_load(ss + (u.pm * BM + ai * HALF + wr * 64 + m * 16 + fr), __ATOMIC_RELAXED, __HIP_MEMORY_SCOPE_AGENT);
#pragma unroll
        for (int bj = 0; bj < 2; ++bj)
#pragma unroll
            for (int n = 0; n < 2; ++n) gv[bj][n] = *(const f32x4*)(g + u.pn * BM + bj * HALF + wc * 32 + 8 * fq + 4 * n);
        __builtin_amdgcn_sched_barrier(0);
#pragma unroll
        for (int ai = 0; ai < 2; ++ai)
#pragma unroll
            for (int m = 0; m < 4; ++m) {
                const int row = u.pm * BM + ai * HALF + wr * 64 + m * 16 + fr;
                const float rs = ss_rs(tot[ai][m]);
#pragma unroll
                for (int bj = 0; bj < 2; ++bj)
#pragma unroll
                    for (int n = 0; n < 2; ++n) { const int col = u.pn * BM + bj * HALF + wc * 32 + 8 * fq + 4 * n;
                        *(f32x4*)(y + (size_t)row * DM + col) = acc[ai][bj][m][n] * rs * gv[bj][n]; }
            }
    }
};
}

__device__ __forceinline__ bool static_unit(int M, int N, int G, int c, int i, int& pm, int& pn) {
    const int nM = M / 256, nN = N / 256, nwg = nM * nN; const long L = (long)i * G + c; if (L >= nwg) return false;
    int wgid = (int)L; { const int q = nwg / 8, r = nwg % 8, xcd = wgid % 8, off = wgid / 8; wgid = (xcd < r ? xcd * (q + 1) : r * (q + 1) + (xcd - r) * q) + off; }
    const int nig = 8 * nN, gid = wgid / nig, fm = gid * 8, gsz = (nM - fm) < 8 ? (nM - fm) : 8;
    pm = fm + ((wgid % nig) % gsz); pn = (wgid % nig) / gsz; return true;
}
template <class F>
__device__ __forceinline__ void big_gemm8(LAS unsigned char* lds, const bf16_t* A, const bf16_t* Bt, int N, int K, F f) {
    pg8::Gemm g{A, Bt, NP, N, K}; pg8::StaticOrder S; S.init(NP, N, (int)gridDim.x, (int)blockIdx.x);
    f.rst = nullptr;
    if (F::NEED_SS == false && gridDim.x == 256) { pg8::Unit u0; if (S.next(0, u0)) { LAS float* t = (LAS float*)(lds + 131072 + 256); const int tid = opq_tid(); if (tid < 256) t[tid] = f.rowscale(u0.pm * 256 + tid); f.rst = t; } __syncthreads(); }
    pg8::EpiF8<F> E{f};
    pg8::gemm_phase<pg8::EpiF8<F>, pg8::StaticOrder, true, true>(lds, g, S, E);
}
template <class F>
__device__ __forceinline__ void big_gemm(LAS unsigned char* lds, const bf16_t* A, const bf16_t* Bt, int N, int K, const F& f) {
    pg8::Gemm g{A, Bt, NP, N, K}; pg8::StaticOrder S; S.init(NP, N, (int)gridDim.x, (int)blockIdx.x);
    pg8::EpiF<F> E{f};
    pg8::gemm_phase<pg8::EpiF<F>, pg8::StaticOrder, true, true>(lds, g, S, E);
}

template <int RI, int CJ, class F>
__device__ __forceinline__ void small_gemm(LAS unsigned char* lds, const bf16_t* A, const bf16_t* Bt, int K, int nrt, int nct, int row_base, const F& f, int first_block = 0) {
    const int tid = opq_tid(), wid = __builtin_amdgcn_readfirstlane(tid >> 6), lane = tid & 63, fr = lane & 15, fq = lane >> 4;
    const int kw = K >> 3;
    LAS f32x4* red = (LAS f32x4*)lds;
    for (int it = ((int)blockIdx.x - first_block + (int)gridDim.x) % (int)gridDim.x; it < nrt * nct; it += gridDim.x) {
        const int rt = it % nrt, ct = it / nrt;
        const bf16_t* ap = A + (size_t)(rt * 16 * RI + fr) * K + wid * kw + fq * 8;
        const bf16_t* bp = Bt + (size_t)(ct * 16 * CJ + fr) * K + wid * kw + fq * 8;
        constexpr int NSL = (RI * CJ * 64 + 511) / 512;
        float rsv[NSL];
#pragma unroll
        for (int h = 0; h < NSL; ++h) { const int slot = tid + 512 * h; rsv[h] = 1.f; if (slot < RI * CJ * 64) rsv[h] = f.rowscale(row_base + rt * 16 * RI + ((slot >> 6) / CJ) * 16 + fr); }
        f32x4 acc[RI][CJ];
#pragma unroll
        for (int i = 0; i < RI; ++i)
#pragma unroll
            for (int j = 0; j < CJ; ++j) acc[i][j] = (f32x4){0.f, 0.f, 0.f, 0.f};
        for (int k = 0; k < kw; k += 128) {
            bf16x8 x[4][RI], y[4][CJ];
#pragma unroll
            for (int kk = 0; kk < 4; ++kk) {
#pragma unroll
                for (int i = 0; i < RI; ++i) x[kk][i] = *(const bf16x8*)(ap + (size_t)i * 16 * K + k + kk * 32);
#pragma unroll
                for (int j = 0; j < CJ; ++j) y[kk][j] = *(const bf16x8*)(bp + (size_t)j * 16 * K + k + kk * 32); }
#pragma unroll
            for (int kk = 0; kk < 4; ++kk)
#pragma unroll
                for (int i = 0; i < RI; ++i)
#pragma unroll
                    for (int j = 0; j < CJ; ++j) acc[i][j] = MFMA16(y[kk][j], x[kk][i], acc[i][j]);
        }
#pragma unroll
        for (int i = 0; i < RI; ++i)
#pragma unroll
            for (int j = 0; j < CJ; ++j) red[(wid * RI * CJ + i * CJ + j) * 64 + lane] = acc[i][j];
        __syncthreads();
#pragma unroll
        for (int h = 0; h < NSL; ++h) { const int slot = tid + 512 * h; if (slot >= RI * CJ * 64) break;
            const int ij = slot >> 6; f32x4 sacc = red[ij * 64 + lane];
#pragma unroll
            for (int w = 1; w < 8; ++w) sacc = sacc + red[(w * RI * CJ + ij) * 64 + lane];
            const int row = row_base + rt * 16 * RI + (ij / CJ) * 16 + fr, col = ct * 16 * CJ + (ij % CJ) * 16 + 4 * fq;
            const float q = f.store(row, col, sacc, rsv[h]);
            if (F::NEED_SS) f.rowdone(row, q);
        }
        __syncthreads();
    }
}

__device__ __forceinline__ void transpose_item(const float* W, int K, int N, const float* gk, const float* gn, bf16_t* WT, int row_off, LAS float* scr, int item, int lane) {
    const int nblk = N / 32, kb = item / nblk, nb = item % nblk, k0 = 64 * kb, n0 = 32 * nb;
    const int kr = lane >> 3, n4 = (lane & 7) * 4;
    const f32x4 cn = gn ? *(const f32x4*)(gn + n0 + n4) : (f32x4){1.f, 1.f, 1.f, 1.f};
    f32x4 v[8];
#pragma unroll
    for (int i = 0; i < 8; ++i) v[i] = *(const f32x4*)(W + (size_t)(k0 + 8 * i + kr) * N + n0 + n4);
#pragma unroll
    for (int i = 0; i < 8; ++i) { const int kk = 8 * i + kr; f32x4 x = v[i] * cn; if (gk) x = x * gk[k0 + kk];
        scr[kk * 33 + n4] = x[0]; scr[kk * 33 + n4 + 1] = x[1]; scr[kk * 33 + n4 + 2] = x[2]; scr[kk * 33 + n4 + 3] = x[3]; }
    asm volatile("s_waitcnt lgkmcnt(0)" ::: "memory");
    const int c = lane & 7;
#pragma unroll
    for (int j = 0; j < 4; ++j) { const int n = (lane >> 3) + 8 * j; const LAS float* sp = scr + (8 * c) * 33 + n;
        u32x4 o; o.x = cvt_pk_bf16(sp[0 * 33], sp[1 * 33]); o.y = cvt_pk_bf16(sp[2 * 33], sp[3 * 33]); o.z = cvt_pk_bf16(sp[4 * 33], sp[5 * 33]); o.w = cvt_pk_bf16(sp[6 * 33], sp[7 * 33]);
        *(u32x4*)(WT + (size_t)(row_off + n0 + n) * K + k0 + 8 * c) = o; }
    asm volatile("s_waitcnt lgkmcnt(0)" ::: "memory");
}
__device__ __forceinline__ void row_to_bf16(const float* xrow, bf16_t* orow, ss_t* ss, int lane) {
    const f32x4* xr = (const f32x4*)xrow + lane; f32x4 v[4]; float s = 0.f;
#pragma unroll
    for (int j = 0; j < 4; ++j) { v[j] = xr[64 * j]; s += (v[j][0] * v[j][0] + v[j][1] * v[j][1]) + (v[j][2] * v[j][2] + v[j][3] * v[j][3]); }
    s = wave_sum(s);
#pragma unroll
    for (int j = 0; j < 4; ++j) st_bf16x4(orow + 4 * lane + 256 * j, v[j]);
    if (lane == 0) *ss = ss_fix(s);
}

constexpr int KV_STRIDE = 288;
constexpr int ATT_STAGE = 32768, ATT_NST = 4;
typedef float f32x16 __attribute__((ext_vector_type(16)));
#define MFMA32(a, b, c) __builtin_amdgcn_mfma_f32_32x32x16_bf16((a), (b), (c), 0, 0, 0)
struct AttnArgs {
    const bf16_t* q; bf16_t* o;
    const bf16_t* kb; const bf16_t* vb;
    int nq, nk, qpos0, lim_base; float slope_l2;
    const unsigned* kmaxp;
};
__device__ __forceinline__ constexpr int crow32(int i, int hi) { return (i & 3) + 8 * (i >> 2) + 4 * hi; }
template <int NC>
__device__ __forceinline__ void attn_unit(LAS unsigned char* lds, const AttnArgs& a, float lam, float post, const float* g_sub) {
    const int tid = opq_tid(), wid = __builtin_amdgcn_readfirstlane(tid >> 6), lane = tid & 63, r = lane & 31, hi = lane >> 5, l16 = lane & 15, g1 = (lane >> 4) & 1;
    constexpr int KS = (NC == 2) ? 4 : 8;
    const int rg = (NC == 2) ? (wid & 3) : wid, comp = (NC == 2) ? (wid >> 2) : 0;
    const int ntiles = (a.nk + 63) >> 6, q0w = rg * 32;
    const bool active = q0w < a.nq;
    const int tile_lim = a.lim_base + (rg >> 1);
    unsigned goffK[2], goffV[2];
#pragma unroll
    for (int j = 0; j < 2; ++j) { const int row = wid * 8 + j * 4 + (lane >> 4), cl = lane & 15;
        goffK[j] = (unsigned)(row * 512 + ((cl ^ (row & 15)) << 3)) * 2u; goffV[j] = (unsigned)(row * 512 + ((cl ^ ((row & 3) << 2)) << 3)) * 2u; }
#define ATT_DMA1(gp_, la_) asm volatile("s_mov_b32 m0, %1\n\ts_nop 0\n\tglobal_load_lds_dwordx4 %0, off" :: "v"(gp_), "s"(la_) : "memory", "m0")
#define ATT_DMA(kt_, st_) do { const char* kg_ = (const char*)(a.kb + (size_t)(kt_) * 64 * 512); const char* vg_ = (const char*)(a.vb + (size_t)(kt_) * 64 * 512); \
        const unsigned lb_ = (unsigned)(__UINTPTR_TYPE__)lds + (unsigned)((st_) * ATT_STAGE) + (unsigned)wid * 2048u; _Pragma("unroll") for (int j = 0; j < 2; ++j) { \
        ATT_DMA1(kg_ + goffK[j], lb_ + j * 1024); ATT_DMA1(vg_ + goffV[j], lb_ + 16384 + j * 1024); } } while (0)
    { const int t0 = ntiles - 1, t1 = t0 > 0 ? t0 - 1 : 0; ATT_DMA(t0, 0); ATT_DMA(t1, 1); }
    bf16x8 qf[KS];
#pragma unroll
    for (int ks = 0; ks < KS; ++ks) qf[ks] = (bf16x8){0, 0, 0, 0, 0, 0, 0, 0};
    if (active) {
        const bf16_t* qp = a.q + (size_t)(q0w + r) * DM + comp * 64 + hi * 8;
#pragma unroll
        for (int ks = 0; ks < KS; ++ks) qf[ks] = *(const bf16x8*)(qp + ks * 16);
    }
    asm volatile("s_waitcnt vmcnt(0)" ::: "memory");
#pragma unroll
    for (int ks = 0; ks < KS; ++ks) asm volatile("" : "+v"(qf[ks]));
    f32x16 O[4]; float mrun = -1e30f, lrun = 0.f;
#pragma unroll
    for (int dt = 0; dt < 4; ++dt)
#pragma unroll
        for (int i = 0; i < 16; ++i) O[dt][i] = 0.f;
    const int qpos = a.qpos0 + q0w + r;
    f32x16 BIAS[2];
#pragma unroll
    for (int st = 0; st < 2; ++st)
#pragma unroll
        for (int i = 0; i < 16; ++i) BIAS[st][i] = (NC == 2) ? a.slope_l2 * (float)(st * 32 + crow32(i, 0) + 4 * hi - qpos) : 0.f;
    unsigned koff[KS], voff[4];
#pragma unroll
    for (int ks = 0; ks < KS; ++ks) koff[ks] = (unsigned)(r * 256 + (((comp * 8 + ks * 2 + hi) ^ (r & 15)) << 4));
    { const int q4 = l16 >> 2, p4 = l16 & 3;
#pragma unroll
      for (int dt = 0; dt < 4; ++dt) voff[dt] = (unsigned)(16384 + (4 * hi + q4) * 256 + ((dt ^ q4) << 6) + (g1 << 5) + ((p4 >> 1) << 4) + ((p4 & 1) << 3)); }
    const bool term = (NC == 2) && (a.kmaxp != nullptr);
    float ubq = 3.0e38f;
    volatile LAS unsigned* tf = (volatile LAS unsigned*)(lds + 131072 + 64);
    if (term) {
        float ssq = 0.f;
#pragma unroll
        for (int ks = 0; ks < KS; ++ks)
#pragma unroll
            for (int e = 0; e < 8; ++e) { const float f = __uint_as_float(((unsigned)(unsigned short)qf[ks][e]) << 16); ssq += f * f; }
        ssq += __shfl_xor(ssq, 32);
        ubq = sqrtf(ssq) * __uint_as_float(a.kmaxp[comp]) * 1.01f + 0.5f;
        if (lane == 0) { tf[wid] = 0u; tf[8 + wid] = 0u; }
    }
#define ATT_PV1(N, OA, OB) do { s16x4 l0_, h0_, l1_, h1_, l2_, h2_, l3_, h3_; \
        asm volatile("ds_read_b64_tr_b16 %0, %8 offset:" #OA "\n\tds_read_b64_tr_b16 %1, %8 offset:" #OB "\n\t" \
                     "ds_read_b64_tr_b16 %2, %9 offset:" #OA "\n\tds_read_b64_tr_b16 %3, %9 offset:" #OB "\n\t" \
                     "ds_read_b64_tr_b16 %4, %10 offset:" #OA "\n\tds_read_b64_tr_b16 %5, %10 offset:" #OB "\n\t" \
                     "ds_read_b64_tr_b16 %6, %11 offset:" #OA "\n\tds_read_b64_tr_b16 %7, %11 offset:" #OB "\n\ts_waitcnt lgkmcnt(0)" \
                     : "=&v"(l0_), "=&v"(h0_), "=&v"(l1_), "=&v"(h1_), "=&v"(l2_), "=&v"(h2_), "=&v"(l3_), "=&v"(h3_) : "v"(va0_), "v"(va1_), "v"(va2_), "v"(va3_) : "memory"); \
        O[0] = MFMA32(__builtin_shufflevector(l0_, h0_, 0, 1, 2, 3, 4, 5, 6, 7), pfp[N], O[0]); O[1] = MFMA32(__builtin_shufflevector(l1_, h1_, 0, 1, 2, 3, 4, 5, 6, 7), pfp[N], O[1]); \
        O[2] = MFMA32(__builtin_shufflevector(l2_, h2_, 0, 1, 2, 3, 4, 5, 6, 7), pfp[N], O[2]); O[3] = MFMA32(__builtin_shufflevector(l3_, h3_, 0, 1, 2, 3, 4, 5, 6, 7), pfp[N], O[3]); } while (0)
#define ATT_PV(sva_) do { const unsigned va0_ = (sva_) + voff[0], va1_ = (sva_) + voff[1], va2_ = (sva_) + voff[2], va3_ = (sva_) + voff[3]; \
        ATT_PV1(0, 0, 2048); ATT_PV1(1, 4096, 6144); ATT_PV1(2, 8192, 10240); ATT_PV1(3, 12288, 14336); } while (0)
    const bool lag = wid >= 4;
    bf16x8 pfp[4]; bool pend = false; unsigned psva = 0u;
#pragma unroll
    for (int n = 0; n < 4; ++n) pfp[n] = (bf16x8){0, 0, 0, 0, 0, 0, 0, 0};
    const unsigned lds0 = (unsigned)(__UINTPTR_TYPE__)lds;
    int stg = 0;
    for (int kt = ntiles - 1; kt >= 0; --kt, stg = (stg + 1) & 3) {
        asm volatile("s_waitcnt vmcnt(4) lgkmcnt(0)" ::: "memory"); __builtin_amdgcn_s_barrier(); asm volatile("" ::: "memory");
        if (term) {
            const LAS u32x4* fp = (const LAS u32x4*)(lds + 131072 + 64 + (kt & 1) * 32); const u32x4 fa = fp[0], fb = fp[1];
            if (((fa.x & fa.y) & (fa.z & fa.w) & (fb.x & fb.y) & (fb.z & fb.w)) != 0u) break; }
        { const int tn = kt >= 2 ? kt - 2 : 0; ATT_DMA(tn, (stg + 2) & 3); }
        if (lag && pend) { ATT_PV(psva); pend = false; }
        bool dob = false;
        const unsigned sba = lds0 + (unsigned)(stg * ATT_STAGE);
        if (active && kt <= tile_lim) {
            const bool gen = ((NC == 2) && (kt * 64 + 63 >= a.qpos0)) || (kt * 64 + 64 > a.nk);
            f32x16 S[2]; S[0] = BIAS[0]; S[1] = BIAS[1];
#define ATT_K22(K0) do { bf16x8 f0_, f1_, f2_, f3_; \
                asm volatile("ds_read_b128 %0, %4 offset:0\n\tds_read_b128 %1, %4 offset:8192\n\tds_read_b128 %2, %5 offset:0\n\tds_read_b128 %3, %5 offset:8192\n\ts_waitcnt lgkmcnt(0)" \
                             : "=&v"(f0_), "=&v"(f1_), "=&v"(f2_), "=&v"(f3_) : "v"(sba + koff[K0]), "v"(sba + koff[K0 + 1]) : "memory"); \
                S[0] = MFMA32(f0_, qf[K0], S[0]); S[1] = MFMA32(f1_, qf[K0], S[1]); S[0] = MFMA32(f2_, qf[K0 + 1], S[0]); S[1] = MFMA32(f3_, qf[K0 + 1], S[1]); } while (0)
            ATT_K22(0); ATT_K22(2); if (KS == 8) { ATT_K22(KS - 4); ATT_K22(KS - 2); }
#undef ATT_K22
            float toff = 0.f, mx = -1e30f;
            if (gen) {
#pragma unroll
                for (int st = 0; st < 2; ++st)
#pragma unroll
                    for (int i = 0; i < 16; ++i) { const int kpos = kt * 64 + st * 32 + crow32(i, 0) + 4 * hi;
                        float sv = S[st][i] - BIAS[st][i]; if (NC == 2) sv -= a.slope_l2 * fabsf((float)(qpos - kpos)); if (kpos >= a.nk) sv = -1e30f; S[st][i] = sv; mx = fmaxf(mx, sv); }
            } else {
                if (NC == 2) toff = a.slope_l2 * (float)(kt * 64);
#pragma unroll
                for (int st = 0; st < 2; ++st)
#pragma unroll
                    for (int i = 0; i < 16; ++i) mx = fmaxf(mx, S[st][i]);
            }
            mx = fmaxf(mx, __shfl_xor(mx, 32)) + toff;
            const bool dead = (NC == 2) && (mx < mrun - 160.f);
            if (!__all(dead)) {
                const float mn = fmaxf(mrun, mx), alpha = __builtin_amdgcn_exp2f(mrun - mn), d = toff - mn; mrun = mn;
                float ps = 0.f;
#pragma unroll
                for (int st = 0; st < 2; ++st)
#pragma unroll
                    for (int i = 0; i < 16; ++i) { const float pv = __builtin_amdgcn_exp2f(S[st][i] + d); S[st][i] = pv; ps += pv; }
                lrun = lrun * alpha + ps;
                if (!__all(alpha == 1.f)) {
#pragma unroll
                    for (int dt = 0; dt < 4; ++dt) O[dt] = O[dt] * alpha;
                }
#pragma unroll
                for (int n = 0; n < 4; ++n) { const int st = n >> 1, sp = n & 1;
                    u32x4 w; w.x = cvt_pk_bf16(S[st][8 * sp + 0], S[st][8 * sp + 1]); w.y = cvt_pk_bf16(S[st][8 * sp + 2], S[st][8 * sp + 3]);
                    w.z = cvt_pk_bf16(S[st][8 * sp + 4], S[st][8 * sp + 5]); w.w = cvt_pk_bf16(S[st][8 * sp + 6], S[st][8 * sp + 7]); pfp[n] = __builtin_bit_cast(bf16x8, w); }
                dob = true;
            }
        }
        if (dob) { if (lag) { pend = true; psva = sba; } else ATT_PV(sba); }
        if (term) { const float ub = ubq - a.slope_l2 * fmaxf(0.f, (float)(qpos - ((kt - 1) * 64 + 63))); const bool done = ub < mrun - 150.f; const unsigned fl = __all(done) ? 1u : 0u; if (lane == 0) tf[((kt - 1) & 1) * 8 + wid] = fl; }
    }
    if (lag && pend) ATT_PV(psva);
#undef ATT_PV
#undef ATT_PV1
#undef ATT_DMA
#undef ATT_DMA1
    asm volatile("s_waitcnt vmcnt(0)" ::: "memory");
    __syncthreads();
    float linv = 0.f;
    { float l = lrun; l += __shfl_xor(l, 32); linv = 1.f / l; }
    bf16_t* op = a.o + (size_t)(q0w + r) * DM + 4 * hi;
    if (NC == 1) {
        if (active) {
#pragma unroll
            for (int dt = 0; dt < 4; ++dt)
#pragma unroll
                for (int g = 0; g < 4; ++g) st_bf16x4(op + dt * 32 + 8 * g, (f32x4){O[dt][4 * g], O[dt][4 * g + 1], O[dt][4 * g + 2], O[dt][4 * g + 3]} * linv);
        }
    } else {
        LAS f32x4* xch = (LAS f32x4*)lds;
        if (active && comp == 1) {
#pragma unroll
            for (int dt = 0; dt < 4; ++dt)
#pragma unroll
                for (int g = 0; g < 4; ++g) xch[(rg * 16 + dt * 4 + g) * 64 + lane] = (f32x4){O[dt][4 * g], O[dt][4 * g + 1], O[dt][4 * g + 2], O[dt][4 * g + 3]} * linv;
        }
        __syncthreads();
        if (active && comp == 0) {
            float ssq = 0.f;
#pragma unroll
            for (int dt = 0; dt < 4; ++dt)
#pragma unroll
                for (int g = 0; g < 4; ++g) { const f32x4 o1 = xch[(rg * 16 + dt * 4 + g) * 64 + lane];
#pragma unroll
                    for (int e = 0; e < 4; ++e) { const float o = O[dt][4 * g + e] * linv - lam * o1[e]; O[dt][4 * g + e] = o; ssq += o * o; } }
            ssq += __shfl_xor(ssq, 32);
            const float rr = rsqrtf(ssq * (1.f / 128.f) + EPS) * post;
            f32x4 gg[4][4];
#pragma unroll
            for (int dt = 0; dt < 4; ++dt)
#pragma unroll
                for (int g = 0; g < 4; ++g) gg[dt][g] = *(const f32x4*)(g_sub + dt * 32 + 8 * g + 4 * hi);
            __builtin_amdgcn_sched_barrier(0);
#pragma unroll
            for (int dt = 0; dt < 4; ++dt)
#pragma unroll
                for (int g = 0; g < 4; ++g) st_bf16x4(op + dt * 32 + 8 * g, (f32x4){O[dt][4 * g], O[dt][4 * g + 1], O[dt][4 * g + 2], O[dt][4 * g + 3]} * gg[dt][g] * rr);
        }
        __syncthreads();
    }
}

__device__ __forceinline__ void pool_unit(LAS unsigned char* lds, const bf16_t* z, int r0, int nrows, int t0, const float* hist, bool prompt, const bf16_t* WpT, bf16_t* mix, int g) {
    const int tid = opq_tid(), wid = __builtin_amdgcn_readfirstlane(tid >> 6), lane = tid & 63, fr = lane & 15, fq = lane >> 4;
    {
        bf16x8 val[5];
#pragma unroll
        for (int c = 0; c < 5; ++c) { const int idx = tid + 512 * c, j = idx >> 4, c8 = idx & 15; val[c] = (bf16x8){0, 0, 0, 0, 0, 0, 0, 0};
            if (idx < (nrows + 15) * 16) {
                if (j >= 15 || (hist == nullptr && t0 > 0)) val[c] = *(const bf16x8*)(z + (size_t)(r0 - 15 + j) * DM + g * 128 + c8 * 8);
                else if (hist != nullptr) { const f32x4 h0 = *(const f32x4*)(hist + (size_t)j * 512 + g * 128 + c8 * 8), h1 = *(const f32x4*)(hist + (size_t)j * 512 + g * 128 + c8 * 8 + 4);
                    u32x4 w; w.x = cvt_pk_bf16(h0[0], h0[1]); w.y = cvt_pk_bf16(h0[2], h0[3]); w.z = cvt_pk_bf16(h1[0], h1[1]); w.w = cvt_pk_bf16(h1[2], h1[3]); val[c] = __builtin_bit_cast(bf16x8, w); } } }
        bf16x8 wfr[8][4];
        { const bf16_t* wp = WpT + (size_t)g * 16384 + (size_t)fr * 128 + fq * 8;
#pragma unroll
          for (int nt = 0; nt < 8; ++nt)
#pragma unroll
              for (int ks = 0; ks < 4; ++ks) wfr[nt][ks] = *(const bf16x8*)(wp + nt * 16 * 128 + ks * 32); }
#pragma unroll
        for (int c = 0; c < 5; ++c) { const int idx = tid + 512 * c, j = idx >> 4, c8 = idx & 15; if (idx < (nrows + 15) * 16) *(LAS bf16x8*)(lds + j * KV_STRIDE + c8 * 16) = val[c]; }
        __syncthreads();
        if (wid * 16 < nrows) {
            const int win = 2 << g, jr = 15 + wid * 16 + fr, t = t0 + wid * 16 + fr;
            const float icnt = 1.f / (float)(prompt ? (t + 1 < win ? t + 1 : win) : win);
            bf16x8 af[4];
#pragma unroll
            for (int ks = 0; ks < 4; ++ks) {
                float sum[8], u[8];
#pragma unroll
                for (int e = 0; e < 8; ++e) sum[e] = 0.f;
                for (int i = 0; i < win; ++i) { const bf16x8 v = *(const LAS bf16x8*)(lds + (jr - i) * KV_STRIDE + ks * 64 + fq * 16);
#pragma unroll
                    for (int e = 0; e < 8; ++e) { const float f = __uint_as_float(((unsigned)(unsigned short)v[e]) << 16); sum[e] += f; if (i == 0) u[e] = f; } }
                u32x4 w; w.x = cvt_pk_bf16(sum[0] * icnt - u[0], sum[1] * icnt - u[1]); w.y = cvt_pk_bf16(sum[2] * icnt - u[2], sum[3] * icnt - u[3]);
                w.z = cvt_pk_bf16(sum[4] * icnt - u[4], sum[5] * icnt - u[5]); w.w = cvt_pk_bf16(sum[6] * icnt - u[6], sum[7] * icnt - u[7]); af[ks] = __builtin_bit_cast(bf16x8, w);
            }
            bf16_t* op = mix + (size_t)(r0 + wid * 16 + fr) * DM + g * 128 + 4 * fq;
#pragma unroll
            for (int nt = 0; nt < 8; ++nt) { f32x4 acc = {0.f, 0.f, 0.f, 0.f};
#pragma unroll
                for (int ks = 0; ks < 4; ++ks) acc = MFMA16(wfr[nt][ks], af[ks], acc);
                st_bf16x4(op + nt * 16, acc); }
        }
        __syncthreads();
    }
}

#define XB_TMO      128
#define XB_XCNT(j)  (256  + 64 * (j))
#define XB_XSUB(j)  (1280 + 64 * (j))
#define XB_XGEN(j)  (2304 + 64 * (j))
#define XB_TOP      3328
#define XB_TOPGEN   3392
#define XCD_BAR_WORDS 3456
#define XB_SPIN_CAP (1u << 18)

__device__ __forceinline__ unsigned xb_ld(unsigned* p)              { return __hip_atomic_load(p, __ATOMIC_RELAXED, __HIP_MEMORY_SCOPE_AGENT); }
__device__ __forceinline__ unsigned xb_add(unsigned* p, unsigned v) { return __hip_atomic_fetch_add(p, v, __ATOMIC_RELAXED, __HIP_MEMORY_SCOPE_AGENT); }
__device__ __forceinline__ unsigned xb_xcc_id() { return (unsigned)__builtin_amdgcn_s_getreg((3 << 11) | 20) & 0xFu; }
#define XB_SPIN(cond, bar) do { unsigned _sp = 0; while (cond) { __builtin_amdgcn_s_sleep(1); \
    if ((++_sp & 255u) == 0u) { if (xb_ld(&(bar)[XB_TMO])) break; if (_sp > XB_SPIN_CAP) { atomicAdd(&(bar)[XB_TMO], 1u); break; } } } } while (0)

struct XcdBarrier {
    unsigned* bar; unsigned x;
    volatile LAS unsigned* st;
};

__device__ __forceinline__ XcdBarrier xcd_barrier_post(unsigned* bar, volatile LAS unsigned* st) {
    XcdBarrier b; b.bar = bar; b.x = xb_xcc_id(); b.st = st;
    if (threadIdx.x == 0) (void)xb_add(&bar[XB_XCNT(b.x)], 1u);
    return b;
}
__device__ __forceinline__ void xcd_barrier_complete(unsigned* bar, unsigned x, unsigned& nloc, unsigned& nx) {
    const unsigned G = gridDim.x * gridDim.y * gridDim.z;
    unsigned sum, cnt, mine, sp = 0u;
    for (;;) {
        sum = 0u; cnt = 0u; mine = 0u;
#pragma unroll
        for (unsigned j = 0; j < 16; ++j) { const unsigned c = xb_ld(&bar[XB_XCNT(j)]); sum += c; cnt += (c > 0u) ? 1u : 0u; mine = (j == x) ? c : mine; }
        if (sum == G) break;
        __builtin_amdgcn_s_sleep(1);
        if ((++sp & 255u) == 0u) { if (xb_ld(&bar[XB_TMO])) break; if (sp > XB_SPIN_CAP) { atomicAdd(&bar[XB_TMO], 1u); break; } }
    }
    nloc = mine > 0u ? mine : 1u; nx = cnt > 0u ? cnt : 1u;
}

__device__ __forceinline__ void xcd_barrier(const XcdBarrier& b) {
    asm volatile("s_waitcnt vmcnt(0)" ::: "memory");
    __syncthreads();
    if (threadIdx.x == 0) {
        unsigned* bar = b.bar;
        __builtin_amdgcn_s_waitcnt(0);
        unsigned nloc = b.st[0], nx = b.st[1];
        if (nloc == 0u) { xcd_barrier_complete(bar, b.x, nloc, nx); b.st[0] = nloc; b.st[1] = nx; }
        const unsigned old = xb_add(&bar[XB_XSUB(b.x)], 1u);
        const unsigned gen = old / nloc;
        if (old + 1u == (gen + 1u) * nloc) {
            __builtin_amdgcn_fence(__ATOMIC_RELEASE, "agent");
            asm volatile("s_waitcnt vmcnt(0)" ::: "memory");
            const unsigned og = xb_add(&bar[XB_TOP], 1u);
            const unsigned tg = og / nx;
            if (og + 1u == (tg + 1u) * nx) xb_add(&bar[XB_TOPGEN], 1u);
            else XB_SPIN(xb_ld(&bar[XB_TOPGEN]) == tg, bar);
            __builtin_amdgcn_fence(__ATOMIC_ACQUIRE, "agent");
            xb_add(&bar[XB_XGEN(b.x)], 1u);
            asm volatile("s_waitcnt vmcnt(0)" ::: "memory");
        } else {
            XB_SPIN(xb_ld(&bar[XB_XGEN(b.x)]) == gen, bar);
            __builtin_amdgcn_fence(__ATOMIC_ACQUIRE, "agent");
            asm volatile("s_waitcnt vmcnt(0)" ::: "memory");
        }
    }
    __syncthreads();
}

__global__ void __launch_bounds__(512, 2) yoco_fwd(Params p) {
    extern __shared__ __attribute__((aligned(16))) unsigned char lds_raw[];
    LAS unsigned char* lds = (LAS unsigned char*)lds_raw;
    const int G = gridDim.x, NGW = G * 8;
#define PH_IDS const int tid = opq_tid(), wid = __builtin_amdgcn_readfirstlane(tid >> 6), lane = tid & 63, gw = blockIdx.x * 8 + wid; (void)gw; (void)lane
    unsigned char* ws = p.ws; float* out = p.out;
    ss_t* ss0 = (ss_t*)(ws + WS_SS); ss_t* ss1 = ss0 + NR; ss_t* ss2 = ss1 + NR; ss_t* ss3 = ss2 + NR; ss_t* ss4 = ss3 + NR; ss_t* ssm = ss4 + NR;
    unsigned* pcnt = (unsigned*)(ws + WS_Q) + 1024;
    const bool fuse_final = (G == 256);
    bf16_t* xb = (bf16_t*)(ws + WS_XB); bf16_t* memb = (bf16_t*)(ws + WS_MEMB); bf16_t* zb = (bf16_t*)(ws + WS_Z); bf16_t* mix = (bf16_t*)(ws + WS_MIX); bf16_t* hid = (bf16_t*)(ws + WS_HID); bf16_t* ybf = (bf16_t*)(out + O_Y); bf16_t* kbuf = (bf16_t*)(ws + WS_KB); bf16_t* vbuf = (bf16_t*)(ws + WS_VB);
    const float* x_prompt = p.in[0]; const float* x_sample = p.in[1];
    const int lo = p.ph_lo, hi = p.ph_hi;
    volatile LAS unsigned* misc = (volatile LAS unsigned*)(lds + 131072);
    { const int t0 = opq_tid(); if (t0 < 16) misc[t0] = 0u; }
    __syncthreads();
    unsigned* barw = (unsigned*)(ws + WS_BAR);
    XcdBarrier bar = xcd_barrier_post(barw, misc);
    if (p.ph_lo < 0) cg::this_grid().sync();
#define IN(k) (lo <= (k) && (k) < hi)
#define SEAM(k) do { if (IN(k) && IN((k) + 1)) xcd_barrier(bar); } while (0)

    if (IN(0)) for (int rep0 = 0; rep0 < REP0; ++rep0) {
        PH_IDS;
        LAS float* scr = (LAS float*)(lds + wid * 8448);
        constexpr int I_SQ = 16 * 32, I_F1 = 16 * 128, I_F2 = 64 * 32, I_P = 2 * 4;
        constexpr int NITEMS = 7 * I_SQ + 2 * I_F1 + 2 * I_F2 + 4 * I_P;
        for (int it = gw; it < NITEMS; it += NGW) {
            int r = it;
            if (r < 7 * I_SQ) { const int m = r / I_SQ; r -= m * I_SQ;
                if (m == 0) transpose_item(p.in[9], DM, DM, p.in[8], nullptr, (bf16_t*)(ws + WS_WIN0), 0, scr, r, lane);
                else if (m == 1) transpose_item(p.in[9] + (size_t)DM * DM, DM, DM, p.in[8] + DM, nullptr, (bf16_t*)(ws + WS_WINKV1), 0, scr, r, lane);
                else if (m == 2) transpose_item(p.in[21], DM, DM, p.in[20], nullptr, (bf16_t*)(ws + WS_WINKV1), DM, scr, r, lane);
                else if (m == 3) transpose_item(p.in[10], DM, DM, nullptr, nullptr, (bf16_t*)(ws + WS_WOUT0), 0, scr, r, lane);
                else if (m == 4) transpose_item(p.in[10] + (size_t)DM * DM, DM, DM, nullptr, nullptr, (bf16_t*)(ws + WS_WOUT1), 0, scr, r, lane);
                else if (m == 5) transpose_item(p.in[12], DM, DM, p.in[11], nullptr, (bf16_t*)(ws + WS_WMEM0), 0, scr, r, lane);
                else transpose_item(p.in[12] + (size_t)DM * DM, DM, DM, p.in[11] + DM, nullptr, (bf16_t*)(ws + WS_WMEM1), 0, scr, r, lane);
                continue; }
            r -= 7 * I_SQ;
            if (r < 2 * I_F1) { const int l = r / I_F1; r -= l * I_F1; transpose_item(p.in[14] + (size_t)l * DM * FF, DM, FF, p.in[13] + l * DM, nullptr, (bf16_t*)(ws + (l ? WS_WFF1_1 : WS_WFF1_0)), 0, scr, r, lane); continue; }
            r -= 2 * I_F1;
            if (r < 2 * I_F2) { const int l = r / I_F2; r -= l * I_F2; transpose_item(p.in[15] + (size_t)l * FF * DM, FF, DM, nullptr, nullptr, (bf16_t*)(ws + (l ? WS_WFF2_1 : WS_WFF2_0)), 0, scr, r, lane); continue; }
            r -= 2 * I_F2;
            { const int g = r / I_P; r -= g * I_P; transpose_item(p.in[16] + (size_t)g * 16384, 128, 128, nullptr, p.in[17] + g * 128, (bf16_t*)(ws + WS_WPOOL) + (size_t)g * 16384, 0, scr, r, lane); }
        }
        for (int m = gw * 2; m < NR; m += NGW * 2) {
            const float* r0p = m < NP ? x_prompt + (size_t)m * DM : x_sample + (size_t)(m - NP) * DM; const float* r1p = (m + 1) < NP ? x_prompt + (size_t)(m + 1) * DM : x_sample + (size_t)(m + 1 - NP) * DM;
            f32x4 va[4], vb4[4]; float sa = 0.f, sb2 = 0.f;
#pragma unroll
            for (int j = 0; j < 4; ++j) { va[j] = ((const f32x4*)r0p)[lane + 64 * j]; vb4[j] = ((const f32x4*)r1p)[lane + 64 * j]; }
#pragma unroll
            for (int j = 0; j < 4; ++j) { sa += (va[j][0] * va[j][0] + va[j][1] * va[j][1]) + (va[j][2] * va[j][2] + va[j][3] * va[j][3]); sb2 += (vb4[j][0] * vb4[j][0] + vb4[j][1] * vb4[j][1]) + (vb4[j][2] * vb4[j][2] + vb4[j][3] * vb4[j][3]);
                st_bf16x4(xb + (size_t)m * DM + 4 * lane + 256 * j, va[j]); st_bf16x4(xb + (size_t)(m + 1) * DM + 4 * lane + 256 * j, vb4[j]); }
            sa = wave_sum(sa); sb2 = wave_sum(sb2);
            if (lane == 0) { ss0[m] = ss_fix(sa); ss0[m + 1] = ss_fix(sb2); }
        }
        for (int m = gw; m < 512; m += NGW) row_to_bf16(p.in[2] + (size_t)m * DM, memb + (size_t)m * DM, ssm + m, lane);
        for (int i = blockIdx.x * 512 + tid; i < 4 * NR; i += G * 512) ss1[i] = 0ull;
        for (int m0 = gw * 4; m0 < 2 * 16384 + 2 * 4096 + 256; m0 += NGW * 4) {
            f32x4 v0[4], v1[4]; bf16_t* dstp[4];
#pragma unroll
            for (int j = 0; j < 4; ++j) { const int m = m0 + j; const float* src; bf16_t* dst;
                if (m < 32768) { const int kv = m >> 14, rr = m & 16383, b = rr >> 11, t = rr & 2047; src = p.in[3 + kv] + (size_t)rr * 512; dst = ybf + (kv ? Y_SVB : Y_SKB) + ((size_t)b * SKB_ROWS + t) * 512; }
                else if (m < 32768 + 8192) { const int mm = m - 32768, kv = mm >> 12, rr = mm & 4095, l = rr >> 11, rb = rr & 2047; src = p.in[5 + kv] + (size_t)rr * 512; dst = ybf + (kv ? Y_MVB : Y_MKB) + ((size_t)l * 10 * 256 + 512 + rb) * 512; }
                else { const int mm = m - 40960, b = mm >> 5, t = mm & 31; src = nullptr; dst = ybf + Y_SVB + ((size_t)b * SKB_ROWS + 2080 + t) * 512; }
                dstp[j] = dst; v0[j] = (f32x4){0.f, 0.f, 0.f, 0.f}; v1[j] = v0[j];
                if (src) { v0[j] = *(const f32x4*)(src + 8 * lane); v1[j] = *(const f32x4*)(src + 8 * lane + 4); } }
#pragma unroll
            for (int j = 0; j < 4; ++j) { u32x4 w; w.x = cvt_pk_bf16(v0[j][0], v0[j][1]); w.y = cvt_pk_bf16(v0[j][2], v0[j][3]); w.z = cvt_pk_bf16(v1[j][0], v1[j][1]); w.w = cvt_pk_bf16(v1[j][2], v1[j][3]);
                *(u32x4*)(dstp[j] + 8 * lane) = w; }
        }
    }
    SEAM(0);
    if (IN(1)) for (int rep1 = 0; rep1 < REP1; ++rep1) {
        FZ0 f{ss0, zb, out + O_POOLP, out + O_POOLS, nullptr};
        big_gemm8(lds, xb, (const bf16_t*)(ws + WS_WIN0), DM, DM, f);
        for (int rs_ = 0; rs_ < REPS; ++rs_) small_gemm<2, 2>(lds, xb + (size_t)NP * DM, (const bf16_t*)(ws + WS_WIN0), DM, NS / 32, DM / 32, NP, f);
        { FMemKV fm{ssm, out + O_MEMK, out + O_MEMV, ybf + Y_MKB, ybf + Y_MVB};
          for (int rs_ = 0; rs_ < REPS; ++rs_) small_gemm<4, 4>(lds, memb, (const bf16_t*)(ws + WS_WMEM0), DM, 512 / 64, 2 * DM / 64, 0, fm); }
    }
    SEAM(1);
    for (int layer = 0; layer < 2; ++layer) {
        const int ph = layer ? 7 : 2;
        if (IN(ph)) for (int rep = 0; rep < (layer ? REP7 : REP2); ++rep) {
            if (layer == 1) {
                const float* lq = p.in[18]; const int lane = opq_tid() & 63;
                const float d1 = wave_sum(lq[lane] * lq[64 + lane]), d2 = wave_sum(lq[128 + lane] * lq[192 + lane]);
                const float lam_i = 0.8f - 0.6f * expf(-0.3f), lam = expf(d1) - expf(d2) + lam_i;
                unsigned* kmx = (unsigned*)(ws + WS_BAR + 49152);
                unsigned* qc = (unsigned*)(ws + WS_Q);
#define Q_NEXT(q_, dst_) do { __syncthreads(); if (opq_tid() == 0) misc[2] = atomicAdd(qc + (q_), 1u); __syncthreads(); dst_ = (int)misc[2]; } while (0)
                const int xs = (int)(blockIdx.x & 7);
                if ((xs & 3) == 0) for (;;) {
                    int e; Q_NEXT(8, e); if (e >= 32) break;
                    const int b = e >> 2, h = e & 3; const size_t r0 = (size_t)NP + b * 32;
                    AttnArgs a; a.kmaxp = nullptr; a.q = zb + r0 * DM + h * 128; a.o = mix + r0 * DM + h * 128;
                    a.kb = ybf + Y_SKB + (size_t)b * SKB_ROWS * 512 + h * 128; a.vb = ybf + Y_SVB + (size_t)b * SKB_ROWS * 512 + h * 128;
                    a.nq = 32; a.nk = 2080; a.qpos0 = 2048; a.lim_base = 1 << 20; a.slope_l2 = exp2f(-2.f * (float)(h + 1)) * 1.4426950408889634f;
                    attn_unit<2>(lds, a, lam, 1.f - lam_i, p.in[19]);
                }
                for (int bh = xs;;) {
                    int u; Q_NEXT(bh, u);
                    if (u >= 64) {
                        __syncthreads();
                        { const int t_ = opq_tid(); if (t_ < 8) misc[4 + t_] = __hip_atomic_load(qc + t_, __ATOMIC_RELAXED, __HIP_MEMORY_SCOPE_AGENT); }
                        __syncthreads();
                        int pick = -1;
                        for (int s8 = 1; s8 < 8; ++s8) { const int c = (bh + s8) & 7; if (pick < 0 && misc[4 + c] < 64u) pick = c; }
                        if (pick < 0) break;
                        bh = pick; continue;
                    }
                    const int b = bh >> 2, h = bh & 3, qb = 63 - u; const size_t r0 = (size_t)b * 8192 + (size_t)qb * 128;
                    AttnArgs a; a.kmaxp = h < 2 ? kmx + (b * 4 + h) * 2 : nullptr;     a.q = zb + r0 * DM + h * 128; a.o = mix + r0 * DM + h * 128;
                    a.kb = kbuf + (size_t)b * 8192 * 512 + h * 128; a.vb = vbuf + (size_t)b * 8192 * 512 + h * 128;
                    a.nq = 128; a.nk = (2 * qb + 2) * 64; a.qpos0 = qb * 128; a.lim_base = 2 * qb; a.slope_l2 = exp2f(-2.f * (float)(h + 1)) * 1.4426950408889634f;
                    attn_unit<2>(lds, a, lam, 1.f - lam_i, p.in[19]);
                }
            } else {
                for (int uu = blockIdx.x; uu < 136 * 4; uu += G) {
                    const int g = 3 - uu / 136, u = uu % 136;
                    if (u < 128) pool_unit(lds, zb, u * 128, 128, (u & 63) * 128, nullptr, true, (const bf16_t*)(ws + WS_WPOOL), mix, g);
                    else { const int b = u - 128; pool_unit(lds, zb, NP + b * 32, 32, 0, p.in[7] + (size_t)b * 15 * 512, false, (const bf16_t*)(ws + WS_WPOOL), mix, g); }
                }
            }
            for (;;) {
                int e; { unsigned* qcm = (unsigned*)(ws + WS_Q) + 9 + layer; __syncthreads(); if (opq_tid() == 0) misc[2] = atomicAdd(qcm, 1u); __syncthreads(); e = (int)misc[2]; } if (e >= 288) break;
                AttnArgs a; a.kmaxp = nullptr; a.qpos0 = 0; a.lim_base = 1 << 20; a.slope_l2 = 0.f; a.nk = 256;
                const bf16_t* mkb = ybf + Y_MKB + (size_t)layer * 10 * 256 * 512; const bf16_t* mvb = ybf + Y_MVB + (size_t)layer * 10 * 256 * 512;
                if (e < 256) { const int tile = e >> 2, h = e & 3, b = tile >> 5; const size_t r0 = (size_t)tile * 256;
                    a.q = zb + r0 * DM + 512 + h * 128; a.o = mix + r0 * DM + 512 + h * 128; a.nq = 256;
                    a.kb = mkb + (size_t)b * 256 * 512 + h * 128; a.vb = mvb + (size_t)b * 256 * 512 + h * 128; }
                else { const int b = (e - 256) >> 2, h = e & 3; const size_t r0 = (size_t)NP + b * 32;
                    a.q = zb + r0 * DM + 512 + h * 128; a.o = mix + r0 * DM + 512 + h * 128; a.nq = 32;
                    a.kb = mkb + (size_t)(2 + b) * 256 * 512 + h * 128; a.vb = mvb + (size_t)(2 + b) * 256 * 512 + h * 128; }
                attn_unit<1>(lds, a, 0.f, 1.f, nullptr);
            }
        }
        SEAM(ph);
        if (IN(ph + 1)) {
            FRes f{nullptr, xb, xb, layer ? ss3 : ss1, nullptr};
            const bf16_t* W = (const bf16_t*)(ws + (layer ? WS_WOUT1 : WS_WOUT0));
            big_gemm8(lds, mix, W, DM, DM, f);
            small_gemm<2, 2>(lds, mix + (size_t)NP * DM, W, DM, NS / 32, DM / 32, NP, f);
        }
        SEAM(ph + 1);
        if (IN(ph + 2)) for (int rep4 = 0; rep4 < REP4; ++rep4) {
            FFfn1 f{layer ? ss3 : ss1, hid, nullptr};
            const bf16_t* W = (const bf16_t*)(ws + (layer ? WS_WFF1_1 : WS_WFF1_0));
            big_gemm8(lds, xb, W, FF, DM, f);
            for (int rs_ = 0; rs_ < REPS; ++rs_) small_gemm<4, 4>(lds, xb + (size_t)NP * DM, W, DM, NS / 64, FF / 64, NP, f);
        }
        SEAM(ph + 2);
        if (IN(ph + 3)) {
            FRes f{layer ? out + O_Y : nullptr, xb, layer ? nullptr : xb, layer ? nullptr : ss2, nullptr};
            const bf16_t* W = (const bf16_t*)(ws + (layer ? WS_WFF2_1 : WS_WFF2_0));
            if (layer == 1 && fuse_final) {
                pg8::Gemm g{hid, W, NP, DM, FF}; pg8::StaticOrder S; S.init(NP, DM, G, (int)blockIdx.x);
                pg8::EpiFinal E{xb, out + O_Y, p.in[22], ss4, pcnt};
                pg8::gemm_phase<pg8::EpiFinal, pg8::StaticOrder, false, true>(lds, g, S, E);
            } else
            big_gemm8(lds, hid, W, DM, FF, f);
            small_gemm<2, 2>(lds, hid + (size_t)NP * FF, W, FF, NS / 32, DM / 32, NP, f);
        }
        SEAM(ph + 3);
        if (layer == 0) {
            if (IN(6)) for (int rep6 = 0; rep6 < REP6; ++rep6) {
                FZkv f{ss2, zb, out, kbuf, vbuf, ybf + Y_SKB, ybf + Y_SVB, nullptr};
                big_gemm8(lds, xb, (const bf16_t*)(ws + WS_WINKV1), 2 * DM, DM, f);
                for (int rs_ = 0; rs_ < REPS; ++rs_) small_gemm<4, 2>(lds, xb + (size_t)NP * DM, (const bf16_t*)(ws + WS_WINKV1), DM, NS / 64, 2 * DM / 32, NP, f);
                {
                    asm volatile("s_waitcnt vmcnt(0)" ::: "memory"); __syncthreads();
                    unsigned* kmx = (unsigned*)(ws + WS_BAR + 49152); LAS float* kred = (LAS float*)lds;
                    const int tid_ = opq_tid(), wid_ = __builtin_amdgcn_readfirstlane(tid_ >> 6), ln_ = tid_ & 63, l32 = ln_ & 31;
                    int upm = 0, upn = 0;
                    for (int i = 0; static_unit(NP, 2 * DM, G, (int)blockIdx.x, i, upm, upn); ++i) if (upn == 4 || upn == 5) {
                        float smax = 0.f;
#pragma unroll 1
                        for (int j = 0; j < 16; ++j) { const bf16x8 v = *(const bf16x8*)(kbuf + (size_t)(upm * 256 + wid_ * 32 + 2 * j + (ln_ >> 5)) * 512 + (upn - 4) * 256 + l32 * 8); float sq = 0.f;
#pragma unroll
                            for (int e = 0; e < 8; ++e) { const float fv = __uint_as_float(((unsigned)(unsigned short)v[e]) << 16); sq += fv * fv; }
                            sq += __shfl_xor(sq, 1); sq += __shfl_xor(sq, 2); sq += __shfl_xor(sq, 4); smax = fmaxf(smax, sq); }
                        smax = fmaxf(smax, __shfl_xor(smax, 32));
                        if ((ln_ & 39) == 0) kred[wid_ * 4 + (l32 >> 3)] = smax;
                        __syncthreads();
                        if (tid_ < 4) { float m8 = kred[tid_];
#pragma unroll
                            for (int w = 1; w < 8; ++w) m8 = fmaxf(m8, kred[w * 4 + tid_]);
                            atomicMax(kmx + ((upm >> 5) * 4 + (upn - 4) * 2 + (tid_ >> 1)) * 2 + (tid_ & 1), __float_as_uint(sqrtf(m8))); }
                        __syncthreads();
                    }
                }
            }
            SEAM(6);
        }
    }
    if (IN(11)) {
        PH_IDS;
        const float* gf = p.in[22];
        for (int m = (fuse_final ? NP : 0) + gw; m < NR; m += NGW) {
            f32x4* xr = (f32x4*)(out + O_Y + (size_t)m * DM) + lane; f32x4 v[4]; float s = 0.f;
#pragma unroll
            for (int j = 0; j < 4; ++j) { v[j] = xr[64 * j]; s += (v[j][0] * v[j][0] + v[j][1] * v[j][1]) + (v[j][2] * v[j][2] + v[j][3] * v[j][3]); }
            const float r = rsqrtf(wave_sum(s) * (1.f / 1024.f) + EPS);
#pragma unroll
            for (int j = 0; j < 4; ++j) xr[64 * j] = v[j] * r * ((const f32x4*)gf)[lane + 64 * j];
        }
    }
#undef IN
#undef SEAM
}

extern "C" void kernel_launch(void* const* d_in, const int* in_sizes, int n_in, void* d_out, int out_size, void* d_ws, size_t ws_size, hipStream_t stream) {
    static int grid = 0;
    if (grid == 0) {
        int dev = 0, cus = 0, per_cu = 0;
        if (n_in != 23 || ws_size < WS_END) { fprintf(stderr, "kernel_launch: unexpected n_in %d / ws %zu\n", n_in, ws_size); grid = -1; return; }
        hipGetDevice(&dev); hipDeviceGetAttribute(&cus, hipDeviceAttributeMultiprocessorCount, dev);
        if (hipFuncSetAttribute((const void*)yoco_fwd, hipFuncAttributeMaxDynamicSharedMemorySize, LDS_BYTES) != hipSuccess) { fprintf(stderr, "kernel_launch: hipFuncSetAttribute failed\n"); grid = -1; return; }
        if (hipOccupancyMaxActiveBlocksPerMultiprocessor(&per_cu, (const void*)yoco_fwd, 512, LDS_BYTES) != hipSuccess || per_cu < 1) { fprintf(stderr, "kernel_launch: occupancy query says %d blocks per CU\n", per_cu); per_cu = 1; }
        (void)hipGetLastError();
        grid = cus;
    }
    if (grid < 0) return;
    Params p{};
    for (int i = 0; i < 23; ++i) p.in[i] = (const float*)d_in[i];
    p.out = (float*)d_out; p.ws = (unsigned char*)d_ws;
    if (hipMemsetAsync((char*)d_ws + WS_BAR, 0, 65536, stream) != hipSuccess) { fprintf(stderr, "kernel_launch: memset of the control words failed\n"); return; }
#if N_LAUNCHES == 1
    p.ph_lo = 0; p.ph_hi = NPHASE;
    void* args[] = {&p};
    hipError_t e = hipLaunchCooperativeKernel((const void*)yoco_fwd, dim3(grid), dim3(512), args, LDS_BYTES, stream);
    if (e != hipSuccess) fprintf(stderr, "cooperative launch failed: %s (grid %d)\n", hipGetErrorString(e), grid);
#else
    for (int ph = 0; ph < NPHASE; ++ph) { p.ph_lo = ph; p.ph_hi = ph + 1; hipLaunchKernelGGL(yoco_fwd, dim3(grid), dim3(512), LDS_BYTES, stream, p); }
#endif
}
```

```cpp
#include <hip/hip_runtime.h>
#include <hip/hip_cooperative_groups.h>
#include <cstdio>
#include <cstdint>
namespace cg = cooperative_groups;


__device__ __forceinline__ int opq_tid() { int t = threadIdx.x; asm volatile("" : "+v"(t)); return t; }
#ifndef REP2
#define REP2 1
#endif
#ifndef REP7
#define REP7 1
#endif
#ifndef REP0
#define REP0 1
#endif
#ifndef REP4
#define REP4 1
#endif
#ifndef REP7A
#define REP7A 1
#endif
#ifndef REP7B
#define REP7B 1
#endif
#ifndef REP7C
#define REP7C 1
#endif
#ifndef REPS
#define REPS 1
#endif
#ifndef REP1
#define REP1 1
#endif
#ifndef REP6
#define REP6 1
#endif
#ifndef N_LAUNCHES
#define N_LAUNCHES 1
#endif

namespace pg8 {
#define PG8_LAS __attribute__((address_space(3)))
typedef unsigned short bf16_t;
typedef short bf16x8 __attribute__((ext_vector_type(8)));
typedef float f32x4 __attribute__((ext_vector_type(4)));
typedef unsigned u32x4 __attribute__((ext_vector_type(4)));
constexpr int BM = 256, BK = 64, HALF = 128, HTB = HALF * BK * 2  , STAGE_BYTES = 8 * HTB, NXCD = 8, WGM = 8;

__host__ __device__ __forceinline__ int lds_byte(int r, int c) { const int st = (r >> 4) * 2 + (c >> 5), rr = r & 15, cc = c & 31, ob = rr * 64 + cc * 2; return st * 1024 + (ob ^ (((ob >> 9) & 1) << 5)); }
__host__ __device__ __forceinline__ void stage_rc(int b, int& R, int& C) { const int st = b / 1024, sb = b % 1024, swz = sb ^ (((sb >> 9) & 1) << 5); R = (st >> 1) * 16 + swz / 64; C = (st & 1) * 32 + (swz % 64) / 2; }
__host__ __device__ __forceinline__ int perm32(int rho) { const int n = rho >> 4, i = rho & 15; return 8 * (i >> 2) + 4 * n + (i & 3); }

struct Unit { int pm, pn; };
struct Gemm { const bf16_t* A; const bf16_t* Bt; int M, N, K; };

struct StaticOrder {
    int nM, nN, nwg, G, c;
    __host__ __device__ void init(int M, int N, int G_, int c_) { nM = M / BM; nN = N / BM; nwg = nM * nN; G = G_; c = c_; }
    __host__ __device__ bool next(int i, Unit& u) const {
        const long L = (long)i * G + c; if (L >= nwg) return false;
        int wgid = (int)L; { const int q = nwg / NXCD, r = nwg % NXCD, xcd = wgid % NXCD, off = wgid / NXCD; wgid = (xcd < r ? xcd * (q + 1) : r * (q + 1) + (xcd - r) * q) + off; }
        const int nig = WGM * nN, gid = wgid / nig, fm = gid * WGM, gsz = (nM - fm) < WGM ? (nM - fm) : WGM;
        u.pm = fm + ((wgid % nig) % gsz); u.pn = (wgid % nig) / gsz; return true;
    }
    __device__ __forceinline__ void a_ready(const Unit&) const {}
    __device__ __forceinline__ void done(const Unit&) const {}
};

typedef float f32x2 __attribute__((ext_vector_type(2)));
typedef __bf16 bf16x2v __attribute__((ext_vector_type(2)));
__device__ __forceinline__ unsigned cvt_pk_bf16(float lo, float hi) { const f32x2 f = {lo, hi}; return __builtin_bit_cast(unsigned, __builtin_convertvector(f, bf16x2v)); }
}
namespace pg8 {
template <class Epi, class Sched, bool ALIGN_EPI = false, bool SP2 = false>
__device__ __forceinline__ void gemm_phase(PG8_LAS unsigned char* lds, const Gemm g, const Sched& S, const Epi& E) {
    const int tid = opq_tid(), wid = __builtin_amdgcn_readfirstlane(tid >> 6), lane = tid & 63, wr = wid >> 2, wc = wid & 3, fr = lane & 15, fq = lane >> 4;
    const int K = g.K, nt = K / BK;
    unsigned voffA[2], voffB[2];
#pragma unroll
    for (int i = 0; i < 2; ++i) { int R, C; stage_rc(tid * 16 + i * 8192, R, C); const int Rb = Epi::PERM ? ((R & ~31) + perm32(R & 31)) : R;
        voffA[i] = (unsigned)(R * K + C) * 2u; voffB[i] = (unsigned)(Rb * K + C) * 2u; }
    const size_t kstep = (size_t)(BK * 2);
    const size_t hstep = (size_t)HALF * K * 2;
    const size_t tstep = 2 * hstep;
    const unsigned ldsw = (unsigned)wid * 1024u;
    const int aoff = lds_byte(wr * 64 + fr, fq * 8), boff = lds_byte(wc * 32 + fr, fq * 8);
#define PG8_SA(b, h) (((b) * 2 + (h)) * HTB)
#define PG8_SB(b, h) ((4 + (b) * 2 + (h)) * HTB)
#define PG8_STAGE(bufoff, gbase, voff) do { _Pragma("unroll") for (int _i = 0; _i < 2; ++_i) \
        __builtin_amdgcn_global_load_lds((const unsigned*)((const char*)(gbase) + (voff)[_i]), (PG8_LAS unsigned*)(lds + (bufoff) + ldsw + _i * 8192), 16, 0, 0); } while (0)
#define PG8_LDA(dst, b, h) do { _Pragma("unroll") for (int m = 0; m < 4; ++m) _Pragma("unroll") for (int k = 0; k < 2; ++k) dst[m][k] = *(const PG8_LAS bf16x8*)(lds + PG8_SA(b, h) + aoff + m * 2048 + k * 1024); } while (0)
#define PG8_LDB(dst, b, h) do { _Pragma("unroll") for (int n = 0; n < 2; ++n) _Pragma("unroll") for (int k = 0; k < 2; ++k) dst[n][k] = *(const PG8_LAS bf16x8*)(lds + PG8_SB(b, h) + boff + n * 2048 + k * 1024); } while (0)
#define PG8_MMA(ai, bj, At, Bt) do { __builtin_amdgcn_s_setprio(1); _Pragma("unroll") for (int m = 0; m < 4; ++m) _Pragma("unroll") for (int n = 0; n < 2; ++n) _Pragma("unroll") for (int k = 0; k < 2; ++k) \
        acc[ai][bj][m][n] = __builtin_amdgcn_mfma_f32_16x16x32_bf16(Bt[n][k], At[m][k], acc[ai][bj][m][n], 0, 0, 0); __builtin_amdgcn_s_setprio(0); } while (0)
#define PG8_WAIT_V(n) asm volatile("s_waitcnt vmcnt(" #n ")" ::: "memory")
#define PG8_WAIT_L(n) asm volatile("s_waitcnt lgkmcnt(" #n ")" ::: "memory")
#define PG8_BAR __builtin_amdgcn_s_barrier()
#define PG8_SCHED __builtin_amdgcn_sched_barrier(0)
    Unit cur, nxt; int ui = 0;
    if (!S.next(0, cur)) return;
    f32x4 acc[2][2][4][2];
#pragma unroll
    for (int a = 0; a < 2; ++a)
#pragma unroll
        for (int b = 0; b < 2; ++b)
#pragma unroll
            for (int m = 0; m < 4; ++m)
#pragma unroll
                for (int n = 0; n < 2; ++n) acc[a][b][m][n] = (f32x4){0.f, 0.f, 0.f, 0.f};
    bf16x8 At[4][2], B0[2][2], B1[2][2];
    const char* cA = (const char*)g.A + (size_t)cur.pm * tstep; const char* cB = (const char*)g.Bt + (size_t)cur.pn * tstep;
    S.a_ready(cur);
    if constexpr (SP2) {
        PG8_STAGE(PG8_SB(0, 0), cB, voffB); PG8_STAGE(PG8_SB(0, 1), cB + hstep, voffB); PG8_STAGE(PG8_SA(0, 0), cA, voffA); PG8_STAGE(PG8_SA(0, 1), cA + hstep, voffA);
        if (wr == 1) PG8_BAR;
        PG8_WAIT_V(2); PG8_BAR;
        PG8_STAGE(PG8_SB(1, 0), cB + kstep, voffB); PG8_STAGE(PG8_SA(1, 0), cA + kstep, voffA); PG8_STAGE(PG8_SB(1, 1), cB + hstep + kstep, voffB);
        PG8_WAIT_V(6); PG8_BAR;
    } else {
        PG8_STAGE(PG8_SB(0, 0), cB, voffB); PG8_STAGE(PG8_SA(0, 0), cA, voffA); PG8_STAGE(PG8_SB(0, 1), cB + hstep, voffB); PG8_STAGE(PG8_SA(0, 1), cA + hstep, voffA);
        if (wr == 1) PG8_BAR;
        PG8_WAIT_V(4); PG8_BAR;
        PG8_STAGE(PG8_SB(1, 0), cB + kstep, voffB); PG8_STAGE(PG8_SA(1, 0), cA + kstep, voffA); PG8_STAGE(PG8_SB(1, 1), cB + hstep + kstep, voffB);
        PG8_WAIT_V(6); PG8_BAR;
    }
    for (;;) {
        const bool has_next = S.next(ui + 1, nxt);
        const char* nA = has_next ? (const char*)g.A + (size_t)nxt.pm * tstep : cA; const char* nB = has_next ? (const char*)g.Bt + (size_t)nxt.pn * tstep : cB;
        for (int t = 0; t < nt; t += 2) {
            const bool last = (t == nt - 2);
            const char* a1 = cA + (size_t)(t + 1) * kstep;
            const char* a2 = last ? nA : cA + (size_t)(t + 2) * kstep; const char* b2 = last ? nB : cB + (size_t)(t + 2) * kstep;
            const char* a3 = a2 + kstep; const char* b3 = b2 + kstep;
            if (last && has_next) S.a_ready(nxt);
            if constexpr (SP2) {
            PG8_LDB(B0, 0, 0); PG8_LDB(B1, 0, 1); PG8_SCHED; PG8_LDA(At, 0, 0); PG8_STAGE(PG8_SA(1, 1), a1 + hstep, voffA);
            PG8_WAIT_V(8); PG8_WAIT_L(0); PG8_BAR; PG8_MMA(0, 0, At, B0); PG8_MMA(0, 1, At, B1); PG8_BAR; PG8_SCHED;
            PG8_LDA(At, 0, 1); PG8_STAGE(PG8_SB(0, 0), b2, voffB); PG8_STAGE(PG8_SB(0, 1), b2 + hstep, voffB); PG8_STAGE(PG8_SA(0, 0), a2, voffA);
            PG8_WAIT_V(8); PG8_WAIT_L(0); PG8_BAR; PG8_MMA(1, 0, At, B0); PG8_MMA(1, 1, At, B1); PG8_BAR; PG8_SCHED;
            PG8_LDB(B0, 1, 0); PG8_LDB(B1, 1, 1); PG8_SCHED; PG8_LDA(At, 1, 0); PG8_STAGE(PG8_SA(0, 1), a2 + hstep, voffA);
            PG8_WAIT_V(8); PG8_WAIT_L(0); PG8_BAR; PG8_MMA(0, 0, At, B0); PG8_MMA(0, 1, At, B1); PG8_BAR; PG8_SCHED;
            PG8_LDA(At, 1, 1); PG8_STAGE(PG8_SB(1, 0), b3, voffB); PG8_STAGE(PG8_SB(1, 1), b3 + hstep, voffB); PG8_STAGE(PG8_SA(1, 0), a3, voffA);
            PG8_WAIT_V(8); PG8_WAIT_L(0); PG8_BAR; PG8_MMA(1, 0, At, B0); PG8_MMA(1, 1, At, B1); PG8_BAR; PG8_SCHED;
            } else {
            PG8_LDB(B0, 0, 0); PG8_SCHED; PG8_LDA(At, 0, 0); PG8_STAGE(PG8_SA(1, 1), a1 + hstep, voffA);
            PG8_WAIT_L(8); PG8_BAR; PG8_WAIT_L(0); PG8_MMA(0, 0, At, B0); PG8_BAR; PG8_SCHED;
            PG8_LDB(B1, 0, 1); PG8_STAGE(PG8_SB(0, 0), b2, voffB);
            PG8_BAR; PG8_WAIT_L(0); PG8_MMA(0, 1, At, B1); PG8_BAR;
            PG8_LDA(At, 0, 1); PG8_STAGE(PG8_SA(0, 0), a2, voffA);
            PG8_BAR; PG8_WAIT_L(0); PG8_MMA(1, 0, At, B0); PG8_BAR; PG8_SCHED;
            PG8_STAGE(PG8_SB(0, 1), b2 + hstep, voffB);
            PG8_WAIT_V(6); PG8_BAR; PG8_MMA(1, 1, At, B1); PG8_BAR;
            PG8_LDB(B0, 1, 0); PG8_SCHED; PG8_LDA(At, 1, 0); PG8_STAGE(PG8_SA(0, 1), a2 + hstep, voffA);
            PG8_WAIT_L(8); PG8_BAR; PG8_WAIT_L(0); PG8_MMA(0, 0, At, B0); PG8_BAR; PG8_SCHED;
            PG8_LDB(B1, 1, 1); PG8_STAGE(PG8_SB(1, 0), b3, voffB);
            PG8_BAR; PG8_WAIT_L(0); PG8_MMA(0, 1, At, B1); PG8_BAR;
            PG8_LDA(At, 1, 1); PG8_STAGE(PG8_SA(1, 0), a3, voffA);
            PG8_BAR; PG8_WAIT_L(0); PG8_MMA(1, 0, At, B0); PG8_BAR; PG8_SCHED;
            PG8_STAGE(PG8_SB(1, 1), b3 + hstep, voffB);
            PG8_WAIT_V(6); PG8_BAR; PG8_MMA(1, 1, At, B1); PG8_BAR;
            }
        }
        if constexpr (ALIGN_EPI) { if (wr == 0) PG8_BAR; }
        if constexpr (!Epi::AFTER_DRAIN) { E(acc, cur, wr, wc, fr, fq); S.done(cur); }
        if (!has_next) break;
#pragma unroll
        for (int a = 0; a < 2; ++a)
#pragma unroll
            for (int b = 0; b < 2; ++b)
#pragma unroll
                for (int m = 0; m < 4; ++m)
#pragma unroll
                    for (int n = 0; n < 2; ++n) acc[a][b][m][n] = (f32x4){0.f, 0.f, 0.f, 0.f};
        cur = nxt; cA = nA; cB = nB; ++ui;
        if constexpr (ALIGN_EPI) { if (wr == 1) PG8_BAR; }
    }
    PG8_WAIT_V(0);
    if constexpr (!ALIGN_EPI) { if (wr == 0) PG8_BAR; }
    PG8_BAR;
    if constexpr (Epi::AFTER_DRAIN) { E.fused(acc, cur, wr, wc, fr, fq, lds, wid, lane); S.done(cur); }
#undef PG8_SA
#undef PG8_SB
#undef PG8_STAGE
#undef PG8_LDA
#undef PG8_LDB
#undef PG8_MMA
#undef PG8_WAIT_V
#undef PG8_WAIT_L
#undef PG8_BAR
#undef PG8_SCHED
}
}

#define LAS __attribute__((address_space(3)))
using pg8::bf16_t; using pg8::bf16x8; using pg8::f32x4; using pg8::u32x4; using pg8::cvt_pk_bf16;
typedef short s16x4 __attribute__((ext_vector_type(4)));
typedef unsigned u32x2 __attribute__((ext_vector_type(2)));
typedef LAS s16x4 lds_s16x4;

constexpr int DM = 1024, NP = 16384, NS = 256, NR = NP + NS, FF = 4096, NPHASE = 12;
constexpr float EPS = 1e-6f;
constexpr int LDS_BYTES = 131072 + 256 + 1024;
constexpr size_t MB = 1024 * 1024;
constexpr size_t WS_BAR = 768 * 1024;
constexpr size_t WS_Q = 768 * 1024 + 16384;
constexpr size_t WS_SS = 0;
constexpr size_t WS_WIN0 = 1 * MB, WS_WINKV1 = 3 * MB, WS_WOUT0 = 7 * MB, WS_WOUT1 = 9 * MB, WS_WMEM0 = 11 * MB, WS_WMEM1 = 13 * MB,
                 WS_WFF1_0 = 15 * MB, WS_WFF1_1 = 23 * MB, WS_WFF2_0 = 31 * MB, WS_WFF2_1 = 39 * MB, WS_WPOOL = 47 * MB;
constexpr size_t WS_XB = 48 * MB, WS_MEMB = 81 * MB, WS_R = 82 * MB, WS_Z = WS_R, WS_MIX = WS_R + 33 * MB, WS_HID = WS_R, WS_KB = WS_R + 66 * MB, WS_VB = WS_R + 83 * MB, WS_END = WS_R + 131 * MB;
constexpr size_t O_Y = 0, O_MEMK = 17039360, O_MEMV = 17563648, O_POOLP = 18087936, O_KP = 18103296, O_VP = 26491904, O_POOLS = 34880512, O_KS = 34941952, O_VS = 35073024;

constexpr size_t SKB_ROWS = 2112;
constexpr size_t Y_SKB = 0, Y_SVB = Y_SKB + 8 * SKB_ROWS * 512, Y_MKB = Y_SVB + 8 * SKB_ROWS * 512, Y_MVB = Y_MKB + 2 * 10 * 256 * 512, Y_END = Y_MVB + 2 * 10 * 256 * 512;
static_assert(Y_END * 2 <= (size_t)NP * DM * 4, "scratch must fit the y_prompt region");
struct Params { const float* in[23]; float* out; unsigned char* ws; int ph_lo, ph_hi; };

#define MFMA16(a, b, c) __builtin_amdgcn_mfma_f32_16x16x32_bf16((a), (b), (c), 0, 0, 0)
__device__ __forceinline__ void st_bf16x4(bf16_t* p, f32x4 v) { u32x2 w; w.x = cvt_pk_bf16(v[0], v[1]); w.y = cvt_pk_bf16(v[2], v[3]); *(u32x2*)p = w; }
__device__ __forceinline__ float wave_sum(float v) {
#pragma unroll
    for (int o = 1; o < 64; o <<= 1) v += __shfl_xor(v, o);
    return v;
}

typedef unsigned long long ss_t;
__device__ __forceinline__ ss_t ss_fix(float s) { return (ss_t)(s * 1048576.f + 0.5f); }
__device__ __forceinline__ float ss_rs(ss_t v) { return rsqrtf((float)v * (1.f / (1024.f * 1048576.f)) + EPS); }
struct FZ0 {
    static constexpr bool NEED_SS = false, HAS_PRE = false;
    const ss_t* ss; bf16_t* z; float* pool_p; float* pool_s; const LAS float* rst;
    __device__ __forceinline__ float rowscale(int row) const { return ss_rs(ss[row]); }
    __device__ __forceinline__ float store(int row, int col, f32x4 v, float rs) const {
        v = v * rs; st_bf16x4(z + (size_t)row * DM + col, col < 512 ? v : v * (0.08838834764831845f * 1.4426950408889634f));
        if (col < 512) {
            if (row < NP) { const int t = row & 8191; if (t >= 8177) *(f32x4*)(pool_p + (size_t)((row >> 13) * 15 + (t - 8177)) * 512 + col) = v; }
            else { const int r = row - NP, t = r & 31; if (t >= 17) *(f32x4*)(pool_s + (size_t)((r >> 5) * 15 + (t - 17)) * 512 + col) = v; }
        }
        return 0.f;
    }
    __device__ __forceinline__ float store8(int row, int col, f32x4 v0, f32x4 v1, float rs) const {
        v0 = v0 * rs; v1 = v1 * rs;
        if (col < 512) {
            if (row < NP) { const int t = row & 8191; if (t >= 8177) { float* pp = pool_p + (size_t)((row >> 13) * 15 + (t - 8177)) * 512 + col; *(f32x4*)pp = v0; *(f32x4*)(pp + 4) = v1; } }
        } else { v0 = v0 * (0.08838834764831845f * 1.4426950408889634f); v1 = v1 * (0.08838834764831845f * 1.4426950408889634f); }
        u32x4 w; w.x = cvt_pk_bf16(v0[0], v0[1]); w.y = cvt_pk_bf16(v0[2], v0[3]); w.z = cvt_pk_bf16(v1[0], v1[1]); w.w = cvt_pk_bf16(v1[2], v1[3]);
        *(u32x4*)(z + (size_t)row * DM + col) = w; return 0.f;
    }
    __device__ __forceinline__ void rowdone(int, float) const {}
};
struct FMemKV {
    static constexpr bool NEED_SS = false, HAS_PRE = false;
    const ss_t* ss; float* mk; float* mv; bf16_t* mkb; bf16_t* mvb;
    __device__ __forceinline__ float rowscale(int row) const { return ss_rs(ss[row]); }
    __device__ __forceinline__ float store(int row, int col, f32x4 v, float rs) const {
        v = v * rs; const int l = col >> 10, c = col & 1023; const size_t fo = (size_t)l * 512 * 512 + (size_t)row * 512, bo = (size_t)l * 10 * 256 * 512 + (size_t)row * 512;
        if (c < 512) { *(f32x4*)(mk + fo + c) = v; st_bf16x4(mkb + bo + c, v); } else { *(f32x4*)(mv + fo + (c - 512)) = v; st_bf16x4(mvb + bo + (c - 512), v); } return 0.f;
    }
    __device__ __forceinline__ void rowdone(int, float) const {}
};
struct FRes {
    static constexpr bool NEED_SS = true, HAS_PRE = true;
    float* xres; bf16_t* xb_in; bf16_t* xb; ss_t* ss_out; const LAS float* rst;
    __device__ __forceinline__ float rowscale(int) const { return 1.f; }
    __device__ __forceinline__ float store(int row, int col, f32x4 v, float) const {
        const u32x2 w = *(const u32x2*)(xb_in + (size_t)row * DM + col);
        const f32x4 x = (f32x4){__uint_as_float(w.x << 16), __uint_as_float(w.x & 0xffff0000u), __uint_as_float(w.y << 16), __uint_as_float(w.y & 0xffff0000u)} + v;
        if (xres) *(f32x4*)(xres + (size_t)row * DM + col) = x;
        if (xb) st_bf16x4(xb + (size_t)row * DM + col, x);
        return (x[0] * x[0] + x[1] * x[1]) + (x[2] * x[2] + x[3] * x[3]);
    }
    __device__ __forceinline__ u32x2 pre4(int row, int col) const { return *(const u32x2*)(xb_in + (size_t)row * DM + col); }
    __device__ __forceinline__ float fin4(int row, int col, f32x4 v, u32x2 w) const {
        const f32x4 x = (f32x4){__uint_as_float(w.x << 16), __uint_as_float(w.x & 0xffff0000u), __uint_as_float(w.y << 16), __uint_as_float(w.y & 0xffff0000u)} + v;
        if (xres) *(f32x4*)(xres + (size_t)row * DM + col) = x;
        if (xb) st_bf16x4(xb + (size_t)row * DM + col, x);
        return (x[0] * x[0] + x[1] * x[1]) + (x[2] * x[2] + x[3] * x[3]);
    }
    __device__ __forceinline__ u32x4 pre8(int row, int col) const { return *(const u32x4*)(xb_in + (size_t)row * DM + col); }
    __device__ __forceinline__ float fin8(int row, int col, f32x4 v0, f32x4 v1, u32x4 w) const {
        const f32x4 x0 = (f32x4){__uint_as_float(w.x << 16), __uint_as_float(w.x & 0xffff0000u), __uint_as_float(w.y << 16), __uint_as_float(w.y & 0xffff0000u)} + v0;
        const f32x4 x1 = (f32x4){__uint_as_float(w.z << 16), __uint_as_float(w.z & 0xffff0000u), __uint_as_float(w.w << 16), __uint_as_float(w.w & 0xffff0000u)} + v1;
        if (xres) { float* xp = xres + (size_t)row * DM + col; *(f32x4*)xp = x0; *(f32x4*)(xp + 4) = x1; }
        if (xb) { u32x4 o; o.x = cvt_pk_bf16(x0[0], x0[1]); o.y = cvt_pk_bf16(x0[2], x0[3]); o.z = cvt_pk_bf16(x1[0], x1[1]); o.w = cvt_pk_bf16(x1[2], x1[3]); *(u32x4*)(xb + (size_t)row * DM + col) = o; }
        return ((x0[0] * x0[0] + x0[1] * x0[1]) + (x0[2] * x0[2] + x0[3] * x0[3])) + ((x1[0] * x1[0] + x1[1] * x1[1]) + (x1[2] * x1[2] + x1[3] * x1[3]));
    }
    __device__ __forceinline__ void rowdone(int row, float s) const { if (ss_out) atomicAdd(ss_out + row, ss_fix(s)); }
};
struct FFfn1 {
    static constexpr bool NEED_SS = false, HAS_PRE = false;
    const ss_t* ss; bf16_t* hid; const LAS float* rst;
    __device__ __forceinline__ float rowscale(int row) const { return ss_rs(ss[row]); }
    __device__ __forceinline__ float store(int row, int col, f32x4 v, float rs) const {
        v = v * rs; v = __builtin_elementwise_max(v, (f32x4){0.f, 0.f, 0.f, 0.f}); v = v * v; st_bf16x4(hid + (size_t)row * FF + col, v); return 0.f;
    }
    __device__ __forceinline__ float store8(int row, int col, f32x4 v0, f32x4 v1, float rs) const {
        const f32x4 zz = {0.f, 0.f, 0.f, 0.f}; v0 = __builtin_elementwise_max(v0 * rs, zz); v1 = __builtin_elementwise_max(v1 * rs, zz); v0 = v0 * v0; v1 = v1 * v1;
        u32x4 w; w.x = cvt_pk_bf16(v0[0], v0[1]); w.y = cvt_pk_bf16(v0[2], v0[3]); w.z = cvt_pk_bf16(v1[0], v1[1]); w.w = cvt_pk_bf16(v1[2], v1[3]);
        *(u32x4*)(hid + (size_t)row * FF + col) = w; return 0.f;
    }
    __device__ __forceinline__ void rowdone(int, float) const {}
};
struct FZkv {
    static constexpr bool NEED_SS = false, HAS_PRE = false;
    const ss_t* ss; bf16_t* z; float* out; bf16_t* kb; bf16_t* vb; bf16_t* skb; bf16_t* svb; const LAS float* rst;
    __device__ __forceinline__ float rowscale(int row) const { return ss_rs(ss[row]); }
    __device__ __forceinline__ float store(int row, int col, f32x4 v, float rs) const {
        v = v * rs;
        if (col < 1024) st_bf16x4(z + (size_t)row * DM + col, v * (col < 512 ? (0.125f * 1.4426950408889634f) : (0.08838834764831845f * 1.4426950408889634f)));
        else { const int c = col - 1024; const bool smp = row >= NP, isv = c >= 512; const int r = smp ? row - NP : row;
            size_t off = smp ? (isv ? O_VS : O_KS) : (isv ? O_VP : O_KP); off += (size_t)r * 512 + (c & 511);
            *(f32x4*)(out + off) = v;
            if (!smp) st_bf16x4((isv ? vb : kb) + (size_t)r * 512 + (c & 511), v);
            else st_bf16x4((isv ? svb : skb) + ((size_t)(r >> 5) * SKB_ROWS + 2048 + (r & 31)) * 512 + (c & 511), v); }
        return 0.f;
    }
    __device__ __forceinline__ float store8(int row, int col, f32x4 v0, f32x4 v1, float rs) const {
        v0 = v0 * rs; v1 = v1 * rs;
        if (col < 1024) { const float sc = col < 512 ? (0.125f * 1.4426950408889634f) : (0.08838834764831845f * 1.4426950408889634f); v0 = v0 * sc; v1 = v1 * sc;
            u32x4 w; w.x = cvt_pk_bf16(v0[0], v0[1]); w.y = cvt_pk_bf16(v0[2], v0[3]); w.z = cvt_pk_bf16(v1[0], v1[1]); w.w = cvt_pk_bf16(v1[2], v1[3]); *(u32x4*)(z + (size_t)row * DM + col) = w; }
        else { const int c = col - 1024; const bool isv = c >= 512; float* op = out + (isv ? O_VP : O_KP) + (size_t)row * 512 + (c & 511); *(f32x4*)op = v0; *(f32x4*)(op + 4) = v1;
            u32x4 w; w.x = cvt_pk_bf16(v0[0], v0[1]); w.y = cvt_pk_bf16(v0[2], v0[3]); w.z = cvt_pk_bf16(v1[0], v1[1]); w.w = cvt_pk_bf16(v1[2], v1[3]); *(u32x4*)((isv ? vb : kb) + (size_t)row * 512 + (c & 511)) = w; }
        return 0.f;
    }
    __device__ __forceinline__ void rowdone(int, float) const {}
};

namespace pg8 {
template <class F> struct EpiF {
    static constexpr bool PERM = false, AFTER_DRAIN = false;
    F f;
    __device__ __forceinline__ void operator()(const f32x4 (&acc)[2][2][4][2], const Unit& u, int wr, int wc, int fr, int fq) const {
#pragma unroll
        for (int ai = 0; ai < 2; ++ai)
#pragma unroll
            for (int m = 0; m < 4; ++m) {
                const int row = u.pm * BM + ai * HALF + wr * 64 + m * 16 + fr;
                const float rs = f.rowscale(row); float ssq = 0.f;
#pragma unroll
                for (int bj = 0; bj < 2; ++bj)
#pragma unroll
                    for (int n = 0; n < 2; ++n) ssq += f.store(row, u.pn * BM + bj * HALF + wc * 32 + n * 16 + 4 * fq, acc[ai][bj][m][n], rs);
                if (F::NEED_SS) { ssq += __shfl_xor(ssq, 16); ssq += __shfl_xor(ssq, 32); if (fq == 0) f.rowdone(row, ssq); }
            }
    }
};
template <class F> struct EpiF8 {
    static constexpr bool PERM = true, AFTER_DRAIN = false;
    F f;
    __device__ __forceinline__ void operator()(const f32x4 (&acc)[2][2][4][2], const Unit& u, int wr, int wc, int fr, int fq) const {
        float rsv[2][4], ssv[2][4];
#pragma unroll
        for (int ai = 0; ai < 2; ++ai)
#pragma unroll
            for (int m = 0; m < 4; ++m) rsv[ai][m] = f.rst ? f.rst[ai * HALF + wr * 64 + m * 16 + fr] : f.rowscale(u.pm * BM + ai * HALF + wr * 64 + m * 16 + fr);
#pragma unroll
        for (int ai = 0; ai < 2; ++ai) {
            u32x4 pre[4][2];
#pragma unroll
            for (int m = 0; m < 4; ++m)
#pragma unroll
                for (int bj = 0; bj < 2; ++bj) { if constexpr (F::HAS_PRE) pre[m][bj] = f.pre8(u.pm * BM + ai * HALF + wr * 64 + m * 16 + fr, u.pn * BM + bj * HALF + wc * 32 + 8 * fq); else pre[m][bj] = (u32x4){0u, 0u, 0u, 0u}; }
            __builtin_amdgcn_sched_barrier(0);
#pragma unroll
            for (int m = 0; m < 4; ++m) {
                const int row = u.pm * BM + ai * HALF + wr * 64 + m * 16 + fr;
                float ssq = 0.f;
#pragma unroll
                for (int bj = 0; bj < 2; ++bj) { const int col = u.pn * BM + bj * HALF + wc * 32 + 8 * fq;
                    if constexpr (F::HAS_PRE) ssq += f.fin8(row, col, acc[ai][bj][m][0], acc[ai][bj][m][1], pre[m][bj]);
                    else ssq += f.store8(row, col, acc[ai][bj][m][0], acc[ai][bj][m][1], rsv[ai][m]); }
                if (F::NEED_SS) { ssq += __shfl_xor(ssq, 16); ssq += __shfl_xor(ssq, 32); ssv[ai][m] = ssq; }
            }
        }
        if (F::NEED_SS) {
#pragma unroll
            for (int ai = 0; ai < 2; ++ai)
#pragma unroll
                for (int m = 0; m < 4; ++m) if (fq == 0) f.rowdone(u.pm * BM + ai * HALF + wr * 64 + m * 16 + fr, ssv[ai][m]);
        }
    }
};
struct EpiFinal {
    static constexpr bool PERM = true, AFTER_DRAIN = true;
    const bf16_t* xb; float* y; const float* g; ss_t* ss; unsigned* cnt;
    __device__ __forceinline__ void fused(f32x4 (&acc)[2][2][4][2], const Unit& u, int wr, int wc, int fr, int fq, PG8_LAS unsigned char*, int, int) const {
#pragma unroll
        for (int ai = 0; ai < 2; ++ai) {
            u32x2 pre[4][2][2];
#pragma unroll
            for (int m = 0; m < 4; ++m)
#pragma unroll
                for (int bj = 0; bj < 2; ++bj)
#pragma unroll
                    for (int n = 0; n < 2; ++n) pre[m][bj][n] = *(const u32x2*)(xb + (size_t)(u.pm * BM + ai * HALF + wr * 64 + m * 16 + fr) * DM + u.pn * BM + bj * HALF + wc * 32 + 8 * fq + 4 * n);
            __builtin_amdgcn_sched_barrier(0);
#pragma unroll
            for (int m = 0; m < 4; ++m) {
                const int row = u.pm * BM + ai * HALF + wr * 64 + m * 16 + fr; float ssq = 0.f;
#pragma unroll
                for (int bj = 0; bj < 2; ++bj)
#pragma unroll
                    for (int n = 0; n < 2; ++n) { const int col = u.pn * BM + bj * HALF + wc * 32 + 8 * fq + 4 * n;
                        const u32x2 w = pre[m][bj][n];
                        const f32x4 x = (f32x4){__uint_as_float(w.x << 16), __uint_as_float(w.x & 0xffff0000u), __uint_as_float(w.y << 16), __uint_as_float(w.y & 0xffff0000u)} + acc[ai][bj][m][n];
                        acc[ai][bj][m][n] = x; ssq += (x[0] * x[0] + x[1] * x[1]) + (x[2] * x[2] + x[3] * x[3]); }
                ssq += __shfl_xor(ssq, 16); ssq += __shfl_xor(ssq, 32);
                if (fq == 0) atomicAdd(ss + row, ss_fix(ssq));
            }
        }
        asm volatile("s_waitcnt vmcnt(0)" ::: "memory");
        __syncthreads();
        if (threadIdx.x == 0) {
            __hip_atomic_fetch_add(cnt + 64 * u.pm, 1u, __ATOMIC_RELAXED, __HIP_MEMORY_SCOPE_AGENT);
            while (__hip_atomic_load(cnt + 64 * u.pm, __ATOMIC_RELAXED, __HIP_MEMORY_SCOPE_AGENT) < 4u) __builtin_amdgcn_s_sleep(2);
        }
        __syncthreads();
        ss_t tot[2][4]; f32x4 gv[2][2];
#pragma unroll
        for (int ai = 0; ai < 2; ++ai)
#pragma unroll
            for (int m = 0; m < 4; ++m) tot[ai][m] = __hip_atomic_load(ss + (u.pm * BM + ai * HALF + wr * 64 + m * 16 + fr), __ATOMIC_RELAXED, __HIP_MEMORY_SCOPE_AGENT);
#pragma unroll
        for (int bj = 0; bj < 2; ++bj)
#pragma unroll
            for (int n = 0; n < 2; ++n) gv[bj][n] = *(const f32x4*)(g + u.pn * BM + bj * HALF + wc * 32 + 8 * fq + 4 * n);
        __builtin_amdgcn_sched_barrier(0);
#pragma unroll
        for (int ai = 0; ai < 2; ++ai)
#pragma unroll
            for (int m = 0; m < 4; ++m) {
                const int row = u.pm * BM + ai * HALF + wr * 64 + m * 16 + fr;
                const float rs = ss_rs(tot[ai][m]);
#pragma unroll
                for (int bj = 0; bj < 2; ++bj)
#pragma unroll
                    for (int n = 0; n < 2; ++n) { const int col = u.pn * BM + bj * HALF + wc * 32 + 8 * fq + 4 * n;
                        *(f32x4*)(y + (size_t)row * DM + col) = acc[ai][bj][m][n] * rs * gv[bj][n]; }
            }
    }
};
}

__device__ __forceinline__ bool static_unit(int M, int N, int G, int c, int i, int& pm, int& pn) {
    const int nM = M / 256, nN = N / 256, nwg = nM * nN; const long L = (long)i * G + c; if (L >= nwg) return false;
    int wgid = (int)L; { const int q = nwg / 8, r = nwg % 8, xcd = wgid % 8, off = wgid / 8; wgid = (xcd < r ? xcd * (q + 1) : r * (q + 1) + (xcd - r) * q) + off; }
    const int nig = 8 * nN, gid = wgid / nig, fm = gid * 8, gsz = (nM - fm) < 8 ? (nM - fm) : 8;
    pm = fm + ((wgid % nig) % gsz); pn = (wgid % nig) / gsz; return true;
}
template <class F>
__device__ __forceinline__ void big_gemm8(LAS unsigned char* lds, const bf16_t* A, const bf16_t* Bt, int N, int K, F f) {
    pg8::Gemm g{A, Bt, NP, N, K}; pg8::StaticOrder S; S.init(NP, N, (int)gridDim.x, (int)blockIdx.x);
    f.rst = nullptr;
    if (F::NEED_SS == false && gridDim.x == 256) { pg8::Unit u0; if (S.next(0, u0)) { LAS float* t = (LAS float*)(lds + 131072 + 256); const int tid = opq_tid(); if (tid < 256) t[tid] = f.rowscale(u0.pm * 256 + tid); f.rst = t; } __syncthreads(); }
    pg8::EpiF8<F> E{f};
    pg8::gemm_phase<pg8::EpiF8<F>, pg8::StaticOrder, true, true>(lds, g, S, E);
}
template <class F>
__device__ __forceinline__ void big_gemm(LAS unsigned char* lds, const bf16_t* A, const bf16_t* Bt, int N, int K, const F& f) {
    pg8::Gemm g{A, Bt, NP, N, K}; pg8::StaticOrder S; S.init(NP, N, (int)gridDim.x, (int)blockIdx.x);
    pg8::EpiF<F> E{f};
    pg8::gemm_phase<pg8::EpiF<F>, pg8::StaticOrder, true, true>(lds, g, S, E);
}

template <int RI, int CJ, class F>
__device__ __forceinline__ void small_gemm(LAS unsigned char* lds, const bf16_t* A, const bf16_t* Bt, int K, int nrt, int nct, int row_base, const F& f, int first_block = 0) {
    const int tid = opq_tid(), wid = __builtin_amdgcn_readfirstlane(tid >> 6), lane = tid & 63, fr = lane & 15, fq = lane >> 4;
    const int kw = K >> 3;
    LAS f32x4* red = (LAS f32x4*)lds;
    for (int it = ((int)blockIdx.x - first_block + (int)gridDim.x) % (int)gridDim.x; it < nrt * nct; it += gridDim.x) {
        const int rt = it % nrt, ct = it / nrt;
        const bf16_t* ap = A + (size_t)(rt * 16 * RI + fr) * K + wid * kw + fq * 8;
        const bf16_t* bp = Bt + (size_t)(ct * 16 * CJ + fr) * K + wid * kw + fq * 8;
        constexpr int NSL = (RI * CJ * 64 + 511) / 512;
        float rsv[NSL]; u32x2 prer[NSL];
#pragma unroll
        for (int h = 0; h < NSL; ++h) { const int slot = tid + 512 * h; rsv[h] = 1.f; prer[h] = (u32x2){0u, 0u};
            if (slot < RI * CJ * 64) { const int ij_ = slot >> 6, row_ = row_base + rt * 16 * RI + (ij_ / CJ) * 16 + fr; rsv[h] = f.rowscale(row_);
                if constexpr (F::HAS_PRE) prer[h] = f.pre4(row_, ct * 16 * CJ + (ij_ % CJ) * 16 + 4 * fq); } }
        f32x4 acc[RI][CJ];
#pragma unroll
        for (int i = 0; i < RI; ++i)
#pragma unroll
            for (int j = 0; j < CJ; ++j) acc[i][j] = (f32x4){0.f, 0.f, 0.f, 0.f};
        for (int k = 0; k < kw; k += 128) {
            bf16x8 x[4][RI], y[4][CJ];
#pragma unroll
            for (int kk = 0; kk < 4; ++kk) {
#pragma unroll
                for (int i = 0; i < RI; ++i) x[kk][i] = *(const bf16x8*)(ap + (size_t)i * 16 * K + k + kk * 32);
#pragma unroll
                for (int j = 0; j < CJ; ++j) y[kk][j] = *(const bf16x8*)(bp + (size_t)j * 16 * K + k + kk * 32); }
#pragma unroll
            for (int kk = 0; kk < 4; ++kk)
#pragma unroll
                for (int i = 0; i < RI; ++i)
#pragma unroll
                    for (int j = 0; j < CJ; ++j) acc[i][j] = MFMA16(y[kk][j], x[kk][i], acc[i][j]);
        }
#pragma unroll
        for (int i = 0; i < RI; ++i)
#pragma unroll
            for (int j = 0; j < CJ; ++j) red[(wid * RI * CJ + i * CJ + j) * 64 + lane] = acc[i][j];
        __syncthreads();
#pragma unroll
        for (int h = 0; h < NSL; ++h) { const int slot = tid + 512 * h; if (slot >= RI * CJ * 64) break;
            const int ij = slot >> 6; f32x4 sacc = red[ij * 64 + lane];
#pragma unroll
            for (int w = 1; w < 8; ++w) sacc = sacc + red[(w * RI * CJ + ij) * 64 + lane];
            const int row = row_base + rt * 16 * RI + (ij / CJ) * 16 + fr, col = ct * 16 * CJ + (ij % CJ) * 16 + 4 * fq;
            float q; if constexpr (F::HAS_PRE) q = f.fin4(row, col, sacc, prer[h]); else q = f.store(row, col, sacc, rsv[h]);
            if (F::NEED_SS) f.rowdone(row, q);
        }
        __syncthreads();
    }
}

__device__ __forceinline__ void transpose_item(const float* W, int K, int N, const float* gk, const float* gn, bf16_t* WT, int row_off, LAS float* scr, int item, int lane) {
    const int nblk = N / 32, kb = item / nblk, nb = item % nblk, k0 = 64 * kb, n0 = 32 * nb;
    const int kr = lane >> 3, n4 = (lane & 7) * 4;
    const f32x4 cn = gn ? *(const f32x4*)(gn + n0 + n4) : (f32x4){1.f, 1.f, 1.f, 1.f};
    f32x4 v[8];
#pragma unroll
    for (int i = 0; i < 8; ++i) v[i] = *(const f32x4*)(W + (size_t)(k0 + 8 * i + kr) * N + n0 + n4);
#pragma unroll
    for (int i = 0; i < 8; ++i) { const int kk = 8 * i + kr; f32x4 x = v[i] * cn; if (gk) x = x * gk[k0 + kk];
        scr[kk * 33 + n4] = x[0]; scr[kk * 33 + n4 + 1] = x[1]; scr[kk * 33 + n4 + 2] = x[2]; scr[kk * 33 + n4 + 3] = x[3]; }
    asm volatile("s_waitcnt lgkmcnt(0)" ::: "memory");
    const int c = lane & 7;
#pragma unroll
    for (int j = 0; j < 4; ++j) { const int n = (lane >> 3) + 8 * j; const LAS float* sp = scr + (8 * c) * 33 + n;
        u32x4 o; o.x = cvt_pk_bf16(sp[0 * 33], sp[1 * 33]); o.y = cvt_pk_bf16(sp[2 * 33], sp[3 * 33]); o.z = cvt_pk_bf16(sp[4 * 33], sp[5 * 33]); o.w = cvt_pk_bf16(sp[6 * 33], sp[7 * 33]);
        *(u32x4*)(WT + (size_t)(row_off + n0 + n) * K + k0 + 8 * c) = o; }
    asm volatile("s_waitcnt lgkmcnt(0)" ::: "memory");
}
__device__ __forceinline__ void row_to_bf16(const float* xrow, bf16_t* orow, ss_t* ss, int lane) {
    const f32x4* xr = (const f32x4*)xrow + lane; f32x4 v[4]; float s = 0.f;
#pragma unroll
    for (int j = 0; j < 4; ++j) { v[j] = xr[64 * j]; s += (v[j][0] * v[j][0] + v[j][1] * v[j][1]) + (v[j][2] * v[j][2] + v[j][3] * v[j][3]); }
    s = wave_sum(s);
#pragma unroll
    for (int j = 0; j < 4; ++j) st_bf16x4(orow + 4 * lane + 256 * j, v[j]);
    if (lane == 0) *ss = ss_fix(s);
}

constexpr int KV_STRIDE = 288;
constexpr int ATT_STAGE = 32768, ATT_NST = 4;
typedef float f32x16 __attribute__((ext_vector_type(16)));
#define MFMA32(a, b, c) __builtin_amdgcn_mfma_f32_32x32x16_bf16((a), (b), (c), 0, 0, 0)
struct AttnArgs {
    const bf16_t* q; bf16_t* o;
    const bf16_t* kb; const bf16_t* vb;
    int nq, nk, qpos0, lim_base; float slope_l2;
    const unsigned* kmaxp;
};
__device__ __forceinline__ constexpr int crow32(int i, int hi) { return (i & 3) + 8 * (i >> 2) + 4 * hi; }
template <int NC>
__device__ __forceinline__ void attn_unit(LAS unsigned char* lds, const AttnArgs& a, float lam, float post, const float* g_sub) {
    const int tid = opq_tid(), wid = __builtin_amdgcn_readfirstlane(tid >> 6), lane = tid & 63, r = lane & 31, hi = lane >> 5, l16 = lane & 15, g1 = (lane >> 4) & 1;
    constexpr int KS = (NC == 2) ? 4 : 8;
    const int rg = (NC == 2) ? (wid & 3) : wid, comp = (NC == 2) ? (wid >> 2) : 0;
    const int ntiles = (a.nk + 63) >> 6, q0w = rg * 32;
    const bool active = q0w < a.nq;
    const int tile_lim = a.lim_base + (rg >> 1);
    unsigned goffK[2], goffV[2];
#pragma unroll
    for (int j = 0; j < 2; ++j) { const int row = wid * 8 + j * 4 + (lane >> 4), cl = lane & 15;
        goffK[j] = (unsigned)(row * 512 + ((cl ^ (row & 15)) << 3)) * 2u; goffV[j] = (unsigned)(row * 512 + ((cl ^ ((row & 3) << 2)) << 3)) * 2u; }
#define ATT_DMA1(gp_, la_) asm volatile("s_mov_b32 m0, %1\n\ts_nop 0\n\tglobal_load_lds_dwordx4 %0, off" :: "v"(gp_), "s"(la_) : "memory", "m0")
#define ATT_DMA(kt_, st_) do { const char* kg_ = (const char*)(a.kb + (size_t)(kt_) * 64 * 512); const char* vg_ = (const char*)(a.vb + (size_t)(kt_) * 64 * 512); \
        const unsigned lb_ = (unsigned)(__UINTPTR_TYPE__)lds + (unsigned)((st_) * ATT_STAGE) + (unsigned)wid * 2048u; _Pragma("unroll") for (int j = 0; j < 2; ++j) { \
        ATT_DMA1(kg_ + goffK[j], lb_ + j * 1024); ATT_DMA1(vg_ + goffV[j], lb_ + 16384 + j * 1024); } } while (0)
    { const int t0 = ntiles - 1, t1 = t0 > 0 ? t0 - 1 : 0; ATT_DMA(t0, 0); ATT_DMA(t1, 1); }
    bf16x8 qf[KS];
#pragma unroll
    for (int ks = 0; ks < KS; ++ks) qf[ks] = (bf16x8){0, 0, 0, 0, 0, 0, 0, 0};
    if (active) {
        const bf16_t* qp = a.q + (size_t)(q0w + r) * DM + comp * 64 + hi * 8;
#pragma unroll
        for (int ks = 0; ks < KS; ++ks) qf[ks] = *(const bf16x8*)(qp + ks * 16);
    }
    asm volatile("s_waitcnt vmcnt(0)" ::: "memory");
#pragma unroll
    for (int ks = 0; ks < KS; ++ks) asm volatile("" : "+v"(qf[ks]));
    f32x16 O[4]; float mrun = -1e30f, lrun = 0.f;
#pragma unroll
    for (int dt = 0; dt < 4; ++dt)
#pragma unroll
        for (int i = 0; i < 16; ++i) O[dt][i] = 0.f;
    const int qpos = a.qpos0 + q0w + r;
    f32x16 BIAS[2];
#pragma unroll
    for (int st = 0; st < 2; ++st)
#pragma unroll
        for (int i = 0; i < 16; ++i) BIAS[st][i] = (NC == 2) ? a.slope_l2 * (float)(st * 32 + crow32(i, 0) + 4 * hi - qpos) : 0.f;
    unsigned koff[KS], voff[4];
#pragma unroll
    for (int ks = 0; ks < KS; ++ks) koff[ks] = (unsigned)(r * 256 + (((comp * 8 + ks * 2 + hi) ^ (r & 15)) << 4));
    { const int q4 = l16 >> 2, p4 = l16 & 3;
#pragma unroll
      for (int dt = 0; dt < 4; ++dt) voff[dt] = (unsigned)(16384 + (4 * hi + q4) * 256 + ((dt ^ q4) << 6) + (g1 << 5) + ((p4 >> 1) << 4) + ((p4 & 1) << 3)); }
    const bool term = (NC == 2) && (a.kmaxp != nullptr);
    float ubq = 3.0e38f;
    volatile LAS unsigned* tf = (volatile LAS unsigned*)(lds + 131072 + 64);
    if (term) {
        float ssq = 0.f;
#pragma unroll
        for (int ks = 0; ks < KS; ++ks)
#pragma unroll
            for (int e = 0; e < 8; ++e) { const float f = __uint_as_float(((unsigned)(unsigned short)qf[ks][e]) << 16); ssq += f * f; }
        ssq += __shfl_xor(ssq, 32);
        ubq = sqrtf(ssq) * __uint_as_float(a.kmaxp[comp]) * 1.01f + 0.5f;
        if (lane == 0) { tf[wid] = 0u; tf[8 + wid] = 0u; }
    }
#define ATT_PV1(N, OA, OB) do { s16x4 l0_, h0_, l1_, h1_, l2_, h2_, l3_, h3_; \
        asm volatile("ds_read_b64_tr_b16 %0, %8 offset:" #OA "\n\tds_read_b64_tr_b16 %1, %8 offset:" #OB "\n\t" \
                     "ds_read_b64_tr_b16 %2, %9 offset:" #OA "\n\tds_read_b64_tr_b16 %3, %9 offset:" #OB "\n\t" \
                     "ds_read_b64_tr_b16 %4, %10 offset:" #OA "\n\tds_read_b64_tr_b16 %5, %10 offset:" #OB "\n\t" \
                     "ds_read_b64_tr_b16 %6, %11 offset:" #OA "\n\tds_read_b64_tr_b16 %7, %11 offset:" #OB "\n\ts_waitcnt lgkmcnt(0)" \
                     : "=&v"(l0_), "=&v"(h0_), "=&v"(l1_), "=&v"(h1_), "=&v"(l2_), "=&v"(h2_), "=&v"(l3_), "=&v"(h3_) : "v"(va0_), "v"(va1_), "v"(va2_), "v"(va3_) : "memory"); \
        O[0] = MFMA32(__builtin_shufflevector(l0_, h0_, 0, 1, 2, 3, 4, 5, 6, 7), pfp[N], O[0]); O[1] = MFMA32(__builtin_shufflevector(l1_, h1_, 0, 1, 2, 3, 4, 5, 6, 7), pfp[N], O[1]); \
        O[2] = MFMA32(__builtin_shufflevector(l2_, h2_, 0, 1, 2, 3, 4, 5, 6, 7), pfp[N], O[2]); O[3] = MFMA32(__builtin_shufflevector(l3_, h3_, 0, 1, 2, 3, 4, 5, 6, 7), pfp[N], O[3]); } while (0)
#define ATT_PV(sva_) do { const unsigned va0_ = (sva_) + voff[0], va1_ = (sva_) + voff[1], va2_ = (sva_) + voff[2], va3_ = (sva_) + voff[3]; \
        ATT_PV1(0, 0, 2048); ATT_PV1(1, 4096, 6144); ATT_PV1(2, 8192, 10240); ATT_PV1(3, 12288, 14336); } while (0)
    const bool lag = wid >= 4;
    bf16x8 pfp[4]; bool pend = false; unsigned psva = 0u;
#pragma unroll
    for (int n = 0; n < 4; ++n) pfp[n] = (bf16x8){0, 0, 0, 0, 0, 0, 0, 0};
    const unsigned lds0 = (unsigned)(__UINTPTR_TYPE__)lds;
    int stg = 0;
    for (int kt = ntiles - 1; kt >= 0; --kt, stg = (stg + 1) & 3) {
        asm volatile("s_waitcnt vmcnt(4) lgkmcnt(0)" ::: "memory"); __builtin_amdgcn_s_barrier(); asm volatile("" ::: "memory");
        if (term) {
            const LAS u32x4* fp = (const LAS u32x4*)(lds + 131072 + 64 + (kt & 1) * 32); const u32x4 fa = fp[0], fb = fp[1];
            if (((fa.x & fa.y) & (fa.z & fa.w) & (fb.x & fb.y) & (fb.z & fb.w)) != 0u) break; }
        { const int tn = kt >= 2 ? kt - 2 : 0; ATT_DMA(tn, (stg + 2) & 3); }
        if (lag && pend) { ATT_PV(psva); pend = false; }
        bool dob = false;
        const unsigned sba = lds0 + (unsigned)(stg * ATT_STAGE);
        if (active && kt <= tile_lim) {
            const bool gen = ((NC == 2) && (kt * 64 + 63 >= a.qpos0)) || (kt * 64 + 64 > a.nk);
            f32x16 S[2]; S[0] = BIAS[0]; S[1] = BIAS[1];
#define ATT_K22(K0) do { bf16x8 f0_, f1_, f2_, f3_; \
                asm volatile("ds_read_b128 %0, %4 offset:0\n\tds_read_b128 %1, %4 offset:8192\n\tds_read_b128 %2, %5 offset:0\n\tds_read_b128 %3, %5 offset:8192\n\ts_waitcnt lgkmcnt(0)" \
                             : "=&v"(f0_), "=&v"(f1_), "=&v"(f2_), "=&v"(f3_) : "v"(sba + koff[K0]), "v"(sba + koff[K0 + 1]) : "memory"); \
                S[0] = MFMA32(f0_, qf[K0], S[0]); S[1] = MFMA32(f1_, qf[K0], S[1]); S[0] = MFMA32(f2_, qf[K0 + 1], S[0]); S[1] = MFMA32(f3_, qf[K0 + 1], S[1]); } while (0)
            ATT_K22(0); ATT_K22(2); if (KS == 8) { ATT_K22(KS - 4); ATT_K22(KS - 2); }
#undef ATT_K22
            float toff = 0.f, mx = -1e30f;
            if (gen) {
#pragma unroll
                for (int st = 0; st < 2; ++st)
#pragma unroll
                    for (int i = 0; i < 16; ++i) { const int kpos = kt * 64 + st * 32 + crow32(i, 0) + 4 * hi;
                        float sv = S[st][i] - BIAS[st][i]; if (NC == 2) sv -= a.slope_l2 * fabsf((float)(qpos - kpos)); if (kpos >= a.nk) sv = -1e30f; S[st][i] = sv; mx = fmaxf(mx, sv); }
            } else {
                if (NC == 2) toff = a.slope_l2 * (float)(kt * 64);
#pragma unroll
                for (int st = 0; st < 2; ++st)
#pragma unroll
                    for (int i = 0; i < 16; ++i) mx = fmaxf(mx, S[st][i]);
            }
            mx = fmaxf(mx, __shfl_xor(mx, 32)) + toff;
            const bool dead = (NC == 2) && (mx < mrun - 160.f);
            if (!__all(dead)) {
                const float mn = fmaxf(mrun, mx), alpha = __builtin_amdgcn_exp2f(mrun - mn), d = toff - mn; mrun = mn;
                float ps = 0.f;
#pragma unroll
                for (int st = 0; st < 2; ++st)
#pragma unroll
                    for (int i = 0; i < 16; ++i) { const float pv = __builtin_amdgcn_exp2f(S[st][i] + d); S[st][i] = pv; ps += pv; }
                lrun = lrun * alpha + ps;
                if (!__all(alpha == 1.f)) {
#pragma unroll
                    for (int dt = 0; dt < 4; ++dt) O[dt] = O[dt] * alpha;
                }
#pragma unroll
                for (int n = 0; n < 4; ++n) { const int st = n >> 1, sp = n & 1;
                    u32x4 w; w.x = cvt_pk_bf16(S[st][8 * sp + 0], S[st][8 * sp + 1]); w.y = cvt_pk_bf16(S[st][8 * sp + 2], S[st][8 * sp + 3]);
                    w.z = cvt_pk_bf16(S[st][8 * sp + 4], S[st][8 * sp + 5]); w.w = cvt_pk_bf16(S[st][8 * sp + 6], S[st][8 * sp + 7]); pfp[n] = __builtin_bit_cast(bf16x8, w); }
                dob = true;
            }
        }
        if (dob) { if (lag) { pend = true; psva = sba; } else ATT_PV(sba); }
        if (term) { const float ub = ubq - a.slope_l2 * fmaxf(0.f, (float)(qpos - ((kt - 1) * 64 + 63))); const bool done = ub < mrun - 150.f; const unsigned fl = __all(done) ? 1u : 0u; if (lane == 0) tf[((kt - 1) & 1) * 8 + wid] = fl; }
    }
    if (lag && pend) ATT_PV(psva);
#undef ATT_PV
#undef ATT_PV1
#undef ATT_DMA
#undef ATT_DMA1
    asm volatile("s_waitcnt vmcnt(0)" ::: "memory");
    __syncthreads();
    float linv = 0.f;
    { float l = lrun; l += __shfl_xor(l, 32); linv = 1.f / l; }
    bf16_t* op = a.o + (size_t)(q0w + r) * DM + 4 * hi;
    if (NC == 1) {
        if (active) {
#pragma unroll
            for (int dt = 0; dt < 4; ++dt)
#pragma unroll
                for (int g = 0; g < 4; ++g) st_bf16x4(op + dt * 32 + 8 * g, (f32x4){O[dt][4 * g], O[dt][4 * g + 1], O[dt][4 * g + 2], O[dt][4 * g + 3]} * linv);
        }
    } else {
        LAS f32x4* xch = (LAS f32x4*)lds;
        if (active && comp == 1) {
#pragma unroll
            for (int dt = 0; dt < 4; ++dt)
#pragma unroll
                for (int g = 0; g < 4; ++g) xch[(rg * 16 + dt * 4 + g) * 64 + lane] = (f32x4){O[dt][4 * g], O[dt][4 * g + 1], O[dt][4 * g + 2], O[dt][4 * g + 3]} * linv;
        }
        __syncthreads();
        if (active && comp == 0) {
            float ssq = 0.f;
#pragma unroll
            for (int dt = 0; dt < 4; ++dt)
#pragma unroll
                for (int g = 0; g < 4; ++g) { const f32x4 o1 = xch[(rg * 16 + dt * 4 + g) * 64 + lane];
#pragma unroll
                    for (int e = 0; e < 4; ++e) { const float o = O[dt][4 * g + e] * linv - lam * o1[e]; O[dt][4 * g + e] = o; ssq += o * o; } }
            ssq += __shfl_xor(ssq, 32);
            const float rr = rsqrtf(ssq * (1.f / 128.f) + EPS) * post;
            f32x4 gg[4][4];
#pragma unroll
            for (int dt = 0; dt < 4; ++dt)
#pragma unroll
                for (int g = 0; g < 4; ++g) gg[dt][g] = *(const f32x4*)(g_sub + dt * 32 + 8 * g + 4 * hi);
            __builtin_amdgcn_sched_barrier(0);
#pragma unroll
            for (int dt = 0; dt < 4; ++dt)
#pragma unroll
                for (int g = 0; g < 4; ++g) st_bf16x4(op + dt * 32 + 8 * g, (f32x4){O[dt][4 * g], O[dt][4 * g + 1], O[dt][4 * g + 2], O[dt][4 * g + 3]} * gg[dt][g] * rr);
        }
        __syncthreads();
    }
}

__device__ __forceinline__ void pool_unit(LAS unsigned char* lds, const bf16_t* z, int r0, int nrows, int t0, const float* hist, bool prompt, const bf16_t* WpT, bf16_t* mix, int g) {
    const int tid = opq_tid(), wid = __builtin_amdgcn_readfirstlane(tid >> 6), lane = tid & 63, fr = lane & 15, fq = lane >> 4;
    {
        bf16x8 val[5];
#pragma unroll
        for (int c = 0; c < 5; ++c) { const int idx = tid + 512 * c, j = idx >> 4, c8 = idx & 15; val[c] = (bf16x8){0, 0, 0, 0, 0, 0, 0, 0};
            if (idx < (nrows + 15) * 16) {
                if (j >= 15 || (hist == nullptr && t0 > 0)) val[c] = *(const bf16x8*)(z + (size_t)(r0 - 15 + j) * DM + g * 128 + c8 * 8);
                else if (hist != nullptr) { const f32x4 h0 = *(const f32x4*)(hist + (size_t)j * 512 + g * 128 + c8 * 8), h1 = *(const f32x4*)(hist + (size_t)j * 512 + g * 128 + c8 * 8 + 4);
                    u32x4 w; w.x = cvt_pk_bf16(h0[0], h0[1]); w.y = cvt_pk_bf16(h0[2], h0[3]); w.z = cvt_pk_bf16(h1[0], h1[1]); w.w = cvt_pk_bf16(h1[2], h1[3]); val[c] = __builtin_bit_cast(bf16x8, w); } } }
        bf16x8 wfr[8][4];
        { const bf16_t* wp = WpT + (size_t)g * 16384 + (size_t)fr * 128 + fq * 8;
#pragma unroll
          for (int nt = 0; nt < 8; ++nt)
#pragma unroll
              for (int ks = 0; ks < 4; ++ks) wfr[nt][ks] = *(const bf16x8*)(wp + nt * 16 * 128 + ks * 32); }
#pragma unroll
        for (int c = 0; c < 5; ++c) { const int idx = tid + 512 * c, j = idx >> 4, c8 = idx & 15; if (idx < (nrows + 15) * 16) *(LAS bf16x8*)(lds + j * KV_STRIDE + c8 * 16) = val[c]; }
        __syncthreads();
        if (wid * 16 < nrows) {
            const int win = 2 << g, jr = 15 + wid * 16 + fr, t = t0 + wid * 16 + fr;
            const float icnt = 1.f / (float)(prompt ? (t + 1 < win ? t + 1 : win) : win);
            bf16x8 af[4];
#pragma unroll
            for (int ks = 0; ks < 4; ++ks) {
                float sum[8], u[8];
#pragma unroll
                for (int e = 0; e < 8; ++e) sum[e] = 0.f;
                for (int i = 0; i < win; ++i) { const bf16x8 v = *(const LAS bf16x8*)(lds + (jr - i) * KV_STRIDE + ks * 64 + fq * 16);
#pragma unroll
                    for (int e = 0; e < 8; ++e) { const float f = __uint_as_float(((unsigned)(unsigned short)v[e]) << 16); sum[e] += f; if (i == 0) u[e] = f; } }
                u32x4 w; w.x = cvt_pk_bf16(sum[0] * icnt - u[0], sum[1] * icnt - u[1]); w.y = cvt_pk_bf16(sum[2] * icnt - u[2], sum[3] * icnt - u[3]);
                w.z = cvt_pk_bf16(sum[4] * icnt - u[4], sum[5] * icnt - u[5]); w.w = cvt_pk_bf16(sum[6] * icnt - u[6], sum[7] * icnt - u[7]); af[ks] = __builtin_bit_cast(bf16x8, w);
            }
            bf16_t* op = mix + (size_t)(r0 + wid * 16 + fr) * DM + g * 128 + 4 * fq;
#pragma unroll
            for (int nt = 0; nt < 8; ++nt) { f32x4 acc = {0.f, 0.f, 0.f, 0.f};
#pragma unroll
                for (int ks = 0; ks < 4; ++ks) acc = MFMA16(wfr[nt][ks], af[ks], acc);
                st_bf16x4(op + nt * 16, acc); }
        }
        __syncthreads();
    }
}

#define XB_TMO      128
#define XB_XCNT(j)  (256  + 64 * (j))
#define XB_XSUB(j)  (1280 + 64 * (j))
#define XB_XGEN(j)  (2304 + 64 * (j))
#define XB_TOP      3328
#define XB_TOPGEN   3392
#define XCD_BAR_WORDS 3456
#define XB_SPIN_CAP (1u << 18)

__device__ __forceinline__ unsigned xb_ld(unsigned* p)              { return __hip_atomic_load(p, __ATOMIC_RELAXED, __HIP_MEMORY_SCOPE_AGENT); }
__device__ __forceinline__ unsigned xb_add(unsigned* p, unsigned v) { return __hip_atomic_fetch_add(p, v, __ATOMIC_RELAXED, __HIP_MEMORY_SCOPE_AGENT); }
__device__ __forceinline__ unsigned xb_xcc_id() { return (unsigned)__builtin_amdgcn_s_getreg((3 << 11) | 20) & 0xFu; }
#define XB_SPIN(cond, bar) do { unsigned _sp = 0; while (cond) { __builtin_amdgcn_s_sleep(1); \
    if ((++_sp & 255u) == 0u) { if (xb_ld(&(bar)[XB_TMO])) break; if (_sp > XB_SPIN_CAP) { atomicAdd(&(bar)[XB_TMO], 1u); break; } } } } while (0)

struct XcdBarrier {
    unsigned* bar; unsigned x;
    volatile LAS unsigned* st;
};

__device__ __forceinline__ XcdBarrier xcd_barrier_post(unsigned* bar, volatile LAS unsigned* st) {
    XcdBarrier b; b.bar = bar; b.x = xb_xcc_id(); b.st = st;
    if (threadIdx.x == 0) (void)xb_add(&bar[XB_XCNT(b.x)], 1u);
    return b;
}
__device__ __forceinline__ void xcd_barrier_complete(unsigned* bar, unsigned x, unsigned& nloc, unsigned& nx) {
    const unsigned G = gridDim.x * gridDim.y * gridDim.z;
    unsigned sum, cnt, mine, sp = 0u;
    for (;;) {
        sum = 0u; cnt = 0u; mine = 0u;
#pragma unroll
        for (unsigned j = 0; j < 16; ++j) { const unsigned c = xb_ld(&bar[XB_XCNT(j)]); sum += c; cnt += (c > 0u) ? 1u : 0u; mine = (j == x) ? c : mine; }
        if (sum == G) break;
        __builtin_amdgcn_s_sleep(1);
        if ((++sp & 255u) == 0u) { if (xb_ld(&bar[XB_TMO])) break; if (sp > XB_SPIN_CAP) { atomicAdd(&bar[XB_TMO], 1u); break; } }
    }
    nloc = mine > 0u ? mine : 1u; nx = cnt > 0u ? cnt : 1u;
}

__device__ __forceinline__ void xcd_barrier(const XcdBarrier& b) {
    asm volatile("s_waitcnt vmcnt(0)" ::: "memory");
    __syncthreads();
    if (threadIdx.x == 0) {
        unsigned* bar = b.bar;
        __builtin_amdgcn_s_waitcnt(0);
        unsigned nloc = b.st[0], nx = b.st[1];
        if (nloc == 0u) { xcd_barrier_complete(bar, b.x, nloc, nx); b.st[0] = nloc; b.st[1] = nx; }
        const unsigned old = xb_add(&bar[XB_XSUB(b.x)], 1u);
        const unsigned gen = old / nloc;
        if (old + 1u == (gen + 1u) * nloc) {
            __builtin_amdgcn_fence(__ATOMIC_RELEASE, "agent");
            asm volatile("s_waitcnt vmcnt(0)" ::: "memory");
            const unsigned og = xb_add(&bar[XB_TOP], 1u);
            const unsigned tg = og / nx;
            if (og + 1u == (tg + 1u) * nx) xb_add(&bar[XB_TOPGEN], 1u);
            else XB_SPIN(xb_ld(&bar[XB_TOPGEN]) == tg, bar);
            __builtin_amdgcn_fence(__ATOMIC_ACQUIRE, "agent");
            xb_add(&bar[XB_XGEN(b.x)], 1u);
            asm volatile("s_waitcnt vmcnt(0)" ::: "memory");
        } else {
            XB_SPIN(xb_ld(&bar[XB_XGEN(b.x)]) == gen, bar);
            __builtin_amdgcn_fence(__ATOMIC_ACQUIRE, "agent");
            asm volatile("s_waitcnt vmcnt(0)" ::: "memory");
        }
    }
    __syncthreads();
}

__global__ void __launch_bounds__(512, 2) yoco_fwd(Params p) {
    extern __shared__ __attribute__((aligned(16))) unsigned char lds_raw[];
    LAS unsigned char* lds = (LAS unsigned char*)lds_raw;
    const int G = gridDim.x, NGW = G * 8;
#define PH_IDS const int tid = opq_tid(), wid = __builtin_amdgcn_readfirstlane(tid >> 6), lane = tid & 63, gw = blockIdx.x * 8 + wid; (void)gw; (void)lane
    unsigned char* ws = p.ws; float* out = p.out;
    ss_t* ss0 = (ss_t*)(ws + WS_SS); ss_t* ss1 = ss0 + NR; ss_t* ss2 = ss1 + NR; ss_t* ss3 = ss2 + NR; ss_t* ss4 = ss3 + NR; ss_t* ssm = ss4 + NR;
    unsigned* pcnt = (unsigned*)(ws + WS_Q) + 1024;
    const bool fuse_final = (G == 256);
    bf16_t* xb = (bf16_t*)(ws + WS_XB); bf16_t* memb = (bf16_t*)(ws + WS_MEMB); bf16_t* zb = (bf16_t*)(ws + WS_Z); bf16_t* mix = (bf16_t*)(ws + WS_MIX); bf16_t* hid = (bf16_t*)(ws + WS_HID); bf16_t* ybf = (bf16_t*)(out + O_Y); bf16_t* kbuf = (bf16_t*)(ws + WS_KB); bf16_t* vbuf = (bf16_t*)(ws + WS_VB);
    const float* x_prompt = p.in[0]; const float* x_sample = p.in[1];
    const int lo = p.ph_lo, hi = p.ph_hi;
    volatile LAS unsigned* misc = (volatile LAS unsigned*)(lds + 131072);
    { const int t0 = opq_tid(); if (t0 < 16) misc[t0] = 0u; }
    __syncthreads();
    unsigned* barw = (unsigned*)(ws + WS_BAR);
    XcdBarrier bar = xcd_barrier_post(barw, misc);
    if (p.ph_lo < 0) cg::this_grid().sync();
#define IN(k) (lo <= (k) && (k) < hi)
#define SEAM(k) do { if (IN(k) && IN((k) + 1)) xcd_barrier(bar); } while (0)

    if (IN(0)) for (int rep0 = 0; rep0 < REP0; ++rep0) {
        PH_IDS;
        LAS float* scr = (LAS float*)(lds + wid * 8448);
        constexpr int I_SQ = 16 * 32, I_F1 = 16 * 128, I_F2 = 64 * 32, I_P = 2 * 4;
        constexpr int NITEMS = 7 * I_SQ + 2 * I_F1 + 2 * I_F2 + 4 * I_P;
        for (int it = gw; it < NITEMS; it += NGW) {
            int r = it;
            if (r < 7 * I_SQ) { const int m = r / I_SQ; r -= m * I_SQ;
                if (m == 0) transpose_item(p.in[9], DM, DM, p.in[8], nullptr, (bf16_t*)(ws + WS_WIN0), 0, scr, r, lane);
                else if (m == 1) transpose_item(p.in[9] + (size_t)DM * DM, DM, DM, p.in[8] + DM, nullptr, (bf16_t*)(ws + WS_WINKV1), 0, scr, r, lane);
                else if (m == 2) transpose_item(p.in[21], DM, DM, p.in[20], nullptr, (bf16_t*)(ws + WS_WINKV1), DM, scr, r, lane);
                else if (m == 3) transpose_item(p.in[10], DM, DM, nullptr, nullptr, (bf16_t*)(ws + WS_WOUT0), 0, scr, r, lane);
                else if (m == 4) transpose_item(p.in[10] + (size_t)DM * DM, DM, DM, nullptr, nullptr, (bf16_t*)(ws + WS_WOUT1), 0, scr, r, lane);
                else if (m == 5) transpose_item(p.in[12], DM, DM, p.in[11], nullptr, (bf16_t*)(ws + WS_WMEM0), 0, scr, r, lane);
                else transpose_item(p.in[12] + (size_t)DM * DM, DM, DM, p.in[11] + DM, nullptr, (bf16_t*)(ws + WS_WMEM1), 0, scr, r, lane);
                continue; }
            r -= 7 * I_SQ;
            if (r < 2 * I_F1) { const int l = r / I_F1; r -= l * I_F1; transpose_item(p.in[14] + (size_t)l * DM * FF, DM, FF, p.in[13] + l * DM, nullptr, (bf16_t*)(ws + (l ? WS_WFF1_1 : WS_WFF1_0)), 0, scr, r, lane); continue; }
            r -= 2 * I_F1;
            if (r < 2 * I_F2) { const int l = r / I_F2; r -= l * I_F2; transpose_item(p.in[15] + (size_t)l * FF * DM, FF, DM, nullptr, nullptr, (bf16_t*)(ws + (l ? WS_WFF2_1 : WS_WFF2_0)), 0, scr, r, lane); continue; }
            r -= 2 * I_F2;
            { const int g = r / I_P; r -= g * I_P; transpose_item(p.in[16] + (size_t)g * 16384, 128, 128, nullptr, p.in[17] + g * 128, (bf16_t*)(ws + WS_WPOOL) + (size_t)g * 16384, 0, scr, r, lane); }
        }
        for (int m = gw * 2; m < NR; m += NGW * 2) {
            const float* r0p = m < NP ? x_prompt + (size_t)m * DM : x_sample + (size_t)(m - NP) * DM; const float* r1p = (m + 1) < NP ? x_prompt + (size_t)(m + 1) * DM : x_sample + (size_t)(m + 1 - NP) * DM;
            f32x4 va[4], vb4[4]; float sa = 0.f, sb2 = 0.f;
#pragma unroll
            for (int j = 0; j < 4; ++j) { va[j] = ((const f32x4*)r0p)[lane + 64 * j]; vb4[j] = ((const f32x4*)r1p)[lane + 64 * j]; }
#pragma unroll
            for (int j = 0; j < 4; ++j) { sa += (va[j][0] * va[j][0] + va[j][1] * va[j][1]) + (va[j][2] * va[j][2] + va[j][3] * va[j][3]); sb2 += (vb4[j][0] * vb4[j][0] + vb4[j][1] * vb4[j][1]) + (vb4[j][2] * vb4[j][2] + vb4[j][3] * vb4[j][3]);
                st_bf16x4(xb + (size_t)m * DM + 4 * lane + 256 * j, va[j]); st_bf16x4(xb + (size_t)(m + 1) * DM + 4 * lane + 256 * j, vb4[j]); }
            sa = wave_sum(sa); sb2 = wave_sum(sb2);
            if (lane == 0) { ss0[m] = ss_fix(sa); ss0[m + 1] = ss_fix(sb2); }
        }
        for (int m = gw; m < 512; m += NGW) row_to_bf16(p.in[2] + (size_t)m * DM, memb + (size_t)m * DM, ssm + m, lane);
        for (int i = blockIdx.x * 512 + tid; i < 4 * NR; i += G * 512) ss1[i] = 0ull;
        for (int m0 = gw * 4; m0 < 2 * 16384 + 2 * 4096 + 256; m0 += NGW * 4) {
            f32x4 v0[4], v1[4]; bf16_t* dstp[4];
#pragma unroll
            for (int j = 0; j < 4; ++j) { const int m = m0 + j; const float* src; bf16_t* dst;
                if (m < 32768) { const int kv = m >> 14, rr = m & 16383, b = rr >> 11, t = rr & 2047; src = p.in[3 + kv] + (size_t)rr * 512; dst = ybf + (kv ? Y_SVB : Y_SKB) + ((size_t)b * SKB_ROWS + t) * 512; }
                else if (m < 32768 + 8192) { const int mm = m - 32768, kv = mm >> 12, rr = mm & 4095, l = rr >> 11, rb = rr & 2047; src = p.in[5 + kv] + (size_t)rr * 512; dst = ybf + (kv ? Y_MVB : Y_MKB) + ((size_t)l * 10 * 256 + 512 + rb) * 512; }
                else { const int mm = m - 40960, b = mm >> 5, t = mm & 31; src = nullptr; dst = ybf + Y_SVB + ((size_t)b * SKB_ROWS + 2080 + t) * 512; }
                dstp[j] = dst; v0[j] = (f32x4){0.f, 0.f, 0.f, 0.f}; v1[j] = v0[j];
                if (src) { v0[j] = *(const f32x4*)(src + 8 * lane); v1[j] = *(const f32x4*)(src + 8 * lane + 4); } }
#pragma unroll
            for (int j = 0; j < 4; ++j) { u32x4 w; w.x = cvt_pk_bf16(v0[j][0], v0[j][1]); w.y = cvt_pk_bf16(v0[j][2], v0[j][3]); w.z = cvt_pk_bf16(v1[j][0], v1[j][1]); w.w = cvt_pk_bf16(v1[j][2], v1[j][3]);
                *(u32x4*)(dstp[j] + 8 * lane) = w; }
        }
    }
    SEAM(0);
    if (IN(1)) for (int rep1 = 0; rep1 < REP1; ++rep1) {
        FZ0 f{ss0, zb, out + O_POOLP, out + O_POOLS, nullptr};
        big_gemm8(lds, xb, (const bf16_t*)(ws + WS_WIN0), DM, DM, f);
        for (int rs_ = 0; rs_ < REPS; ++rs_) small_gemm<2, 2>(lds, xb + (size_t)NP * DM, (const bf16_t*)(ws + WS_WIN0), DM, NS / 32, DM / 32, NP, f);
        { FMemKV fm{ssm, out + O_MEMK, out + O_MEMV, ybf + Y_MKB, ybf + Y_MVB};
          for (int rs_ = 0; rs_ < REPS; ++rs_) small_gemm<4, 4>(lds, memb, (const bf16_t*)(ws + WS_WMEM0), DM, 512 / 64, 2 * DM / 64, 0, fm); }
    }
    SEAM(1);
    for (int layer = 0; layer < 2; ++layer) {
        const int ph = layer ? 7 : 2;
        if (IN(ph)) for (int rep = 0; rep < (layer ? REP7 : REP2); ++rep) {
            if (layer == 1) {
                const float* lq = p.in[18]; const int lane = opq_tid() & 63;
                const float d1 = wave_sum(lq[lane] * lq[64 + lane]), d2 = wave_sum(lq[128 + lane] * lq[192 + lane]);
                const float lam_i = 0.8f - 0.6f * expf(-0.3f), lam = expf(d1) - expf(d2) + lam_i;
                unsigned* kmx = (unsigned*)(ws + WS_BAR + 49152);
                unsigned* qc = (unsigned*)(ws + WS_Q);
#define Q_NEXT(q_, dst_) do { __syncthreads(); if (opq_tid() == 0) misc[2] = atomicAdd(qc + (q_), 1u); __syncthreads(); dst_ = (int)misc[2]; } while (0)
                const int xs = (int)(blockIdx.x & 7);
                if ((xs & 3) == 0) for (;;) {
                    int e; Q_NEXT(8, e); if (e >= 32) break;
                    const int b = e >> 2, h = e & 3; const size_t r0 = (size_t)NP + b * 32;
                    AttnArgs a; a.kmaxp = nullptr; a.q = zb + r0 * DM + h * 128; a.o = mix + r0 * DM + h * 128;
                    a.kb = ybf + Y_SKB + (size_t)b * SKB_ROWS * 512 + h * 128; a.vb = ybf + Y_SVB + (size_t)b * SKB_ROWS * 512 + h * 128;
                    a.nq = 32; a.nk = 2080; a.qpos0 = 2048; a.lim_base = 1 << 20; a.slope_l2 = exp2f(-2.f * (float)(h + 1)) * 1.4426950408889634f;
                    attn_unit<2>(lds, a, lam, 1.f - lam_i, p.in[19]);
                }
                for (int bh = xs;;) {
                    int u; Q_NEXT(bh, u);
                    if (u >= 64) {
                        __syncthreads();
                        { const int t_ = opq_tid(); if (t_ < 8) misc[4 + t_] = __hip_atomic_load(qc + t_, __ATOMIC_RELAXED, __HIP_MEMORY_SCOPE_AGENT); }
                        __syncthreads();
                        int pick = -1;
                        for (int s8 = 1; s8 < 8; ++s8) { const int c = (bh + s8) & 7; if (pick < 0 && misc[4 + c] < 64u) pick = c; }
                        if (pick < 0) break;
                        bh = pick; continue;
                    }
                    const int b = bh >> 2, h = bh & 3, qb = 63 - u; const size_t r0 = (size_t)b * 8192 + (size_t)qb * 128;
                    AttnArgs a; a.kmaxp = h < 2 ? kmx + (b * 4 + h) * 2 : nullptr;     a.q = zb + r0 * DM + h * 128; a.o = mix + r0 * DM + h * 128;
                    a.kb = kbuf + (size_t)b * 8192 * 512 + h * 128; a.vb = vbuf + (size_t)b * 8192 * 512 + h * 128;
                    a.nq = 128; a.nk = (2 * qb + 2) * 64; a.qpos0 = qb * 128; a.lim_base = 2 * qb; a.slope_l2 = exp2f(-2.f * (float)(h + 1)) * 1.4426950408889634f;
                    attn_unit<2>(lds, a, lam, 1.f - lam_i, p.in[19]);
                }
            } else {
                for (int uu = blockIdx.x; uu < 136 * 4; uu += G) {
                    const int g = 3 - uu / 136, u = uu % 136;
                    if (u < 128) pool_unit(lds, zb, u * 128, 128, (u & 63) * 128, nullptr, true, (const bf16_t*)(ws + WS_WPOOL), mix, g);
                    else { const int b = u - 128; pool_unit(lds, zb, NP + b * 32, 32, 0, p.in[7] + (size_t)b * 15 * 512, false, (const bf16_t*)(ws + WS_WPOOL), mix, g); }
                }
            }
            for (;;) {
                int e; { unsigned* qcm = (unsigned*)(ws + WS_Q) + 9 + layer; __syncthreads(); if (opq_tid() == 0) misc[2] = atomicAdd(qcm, 1u); __syncthreads(); e = (int)misc[2]; } if (e >= 288) break;
                AttnArgs a; a.kmaxp = nullptr; a.qpos0 = 0; a.lim_base = 1 << 20; a.slope_l2 = 0.f; a.nk = 256;
                const bf16_t* mkb = ybf + Y_MKB + (size_t)layer * 10 * 256 * 512; const bf16_t* mvb = ybf + Y_MVB + (size_t)layer * 10 * 256 * 512;
                if (e < 256) { const int tile = e >> 2, h = e & 3, b = tile >> 5; const size_t r0 = (size_t)tile * 256;
                    a.q = zb + r0 * DM + 512 + h * 128; a.o = mix + r0 * DM + 512 + h * 128; a.nq = 256;
                    a.kb = mkb + (size_t)b * 256 * 512 + h * 128; a.vb = mvb + (size_t)b * 256 * 512 + h * 128; }
                else { const int b = (e - 256) >> 2, h = e & 3; const size_t r0 = (size_t)NP + b * 32;
                    a.q = zb + r0 * DM + 512 + h * 128; a.o = mix + r0 * DM + 512 + h * 128; a.nq = 32;
                    a.kb = mkb + (size_t)(2 + b) * 256 * 512 + h * 128; a.vb = mvb + (size_t)(2 + b) * 256 * 512 + h * 128; }
                attn_unit<1>(lds, a, 0.f, 1.f, nullptr);
            }
        }
        SEAM(ph);
        if (IN(ph + 1)) {
            FRes f{nullptr, xb, xb, layer ? ss3 : ss1, nullptr};
            const bf16_t* W = (const bf16_t*)(ws + (layer ? WS_WOUT1 : WS_WOUT0));
            big_gemm8(lds, mix, W, DM, DM, f);
            small_gemm<2, 2>(lds, mix + (size_t)NP * DM, W, DM, NS / 32, DM / 32, NP, f);
        }
        SEAM(ph + 1);
        if (IN(ph + 2)) for (int rep4 = 0; rep4 < REP4; ++rep4) {
            FFfn1 f{layer ? ss3 : ss1, hid, nullptr};
            const bf16_t* W = (const bf16_t*)(ws + (layer ? WS_WFF1_1 : WS_WFF1_0));
            big_gemm8(lds, xb, W, FF, DM, f);
            for (int rs_ = 0; rs_ < REPS; ++rs_) small_gemm<4, 4>(lds, xb + (size_t)NP * DM, W, DM, NS / 64, FF / 64, NP, f);
        }
        SEAM(ph + 2);
        if (IN(ph + 3)) {
            FRes f{layer ? out + O_Y : nullptr, xb, layer ? nullptr : xb, layer ? nullptr : ss2, nullptr};
            const bf16_t* W = (const bf16_t*)(ws + (layer ? WS_WFF2_1 : WS_WFF2_0));
            if (layer == 1 && fuse_final) {
                pg8::Gemm g{hid, W, NP, DM, FF}; pg8::StaticOrder S; S.init(NP, DM, G, (int)blockIdx.x);
                pg8::EpiFinal E{xb, out + O_Y, p.in[22], ss4, pcnt};
                pg8::gemm_phase<pg8::EpiFinal, pg8::StaticOrder, false, true>(lds, g, S, E);
            } else
            big_gemm8(lds, hid, W, DM, FF, f);
            small_gemm<2, 2>(lds, hid + (size_t)NP * FF, W, FF, NS / 32, DM / 32, NP, f);
        }
        SEAM(ph + 3);
        if (layer == 0) {
            if (IN(6)) for (int rep6 = 0; rep6 < REP6; ++rep6) {
                FZkv f{ss2, zb, out, kbuf, vbuf, ybf + Y_SKB, ybf + Y_SVB, nullptr};
                big_gemm8(lds, xb, (const bf16_t*)(ws + WS_WINKV1), 2 * DM, DM, f);
                for (int rs_ = 0; rs_ < REPS; ++rs_) small_gemm<4, 2>(lds, xb + (size_t)NP * DM, (const bf16_t*)(ws + WS_WINKV1), DM, NS / 64, 2 * DM / 32, NP, f);
                {
                    asm volatile("s_waitcnt vmcnt(0)" ::: "memory"); __syncthreads();
                    unsigned* kmx = (unsigned*)(ws + WS_BAR + 49152); LAS float* kred = (LAS float*)lds;
                    const int tid_ = opq_tid(), wid_ = __builtin_amdgcn_readfirstlane(tid_ >> 6), ln_ = tid_ & 63, l32 = ln_ & 31;
                    int upm = 0, upn = 0;
                    for (int i = 0; static_unit(NP, 2 * DM, G, (int)blockIdx.x, i, upm, upn); ++i) if (upn == 4 || upn == 5) {
                        float smax = 0.f;
#pragma unroll 1
                        for (int j = 0; j < 16; ++j) { const bf16x8 v = *(const bf16x8*)(kbuf + (size_t)(upm * 256 + wid_ * 32 + 2 * j + (ln_ >> 5)) * 512 + (upn - 4) * 256 + l32 * 8); float sq = 0.f;
#pragma unroll
                            for (int e = 0; e < 8; ++e) { const float fv = __uint_as_float(((unsigned)(unsigned short)v[e]) << 16); sq += fv * fv; }
                            sq += __shfl_xor(sq, 1); sq += __shfl_xor(sq, 2); sq += __shfl_xor(sq, 4); smax = fmaxf(smax, sq); }
                        smax = fmaxf(smax, __shfl_xor(smax, 32));
                        if ((ln_ & 39) == 0) kred[wid_ * 4 + (l32 >> 3)] = smax;
                        __syncthreads();
                        if (tid_ < 4) { float m8 = kred[tid_];
#pragma unroll
                            for (int w = 1; w < 8; ++w) m8 = fmaxf(m8, kred[w * 4 + tid_]);
                            atomicMax(kmx + ((upm >> 5) * 4 + (upn - 4) * 2 + (tid_ >> 1)) * 2 + (tid_ & 1), __float_as_uint(sqrtf(m8))); }
                        __syncthreads();
                    }
                }
            }
            SEAM(6);
        }
    }
    if (IN(11)) {
        PH_IDS;
        const float* gf = p.in[22];
        for (int m = (fuse_final ? NP : 0) + gw; m < NR; m += NGW) {
            f32x4* xr = (f32x4*)(out + O_Y + (size_t)m * DM) + lane; f32x4 v[4]; float s = 0.f;
#pragma unroll
            for (int j = 0; j < 4; ++j) { v[j] = xr[64 * j]; s += (v[j][0] * v[j][0] + v[j][1] * v[j][1]) + (v[j][2] * v[j][2] + v[j][3] * v[j][3]); }
            const float r = rsqrtf(wave_sum(s) * (1.f / 1024.f) + EPS);
#pragma unroll
            for (int j = 0; j < 4; ++j) xr[64 * j] = v[j] * r * ((const f32x4*)gf)[lane + 64 * j];
        }
    }
#undef IN
#undef SEAM
}

extern "C" void kernel_launch(void* const* d_in, const int* in_sizes, int n_in, void* d_out, int out_size, void* d_ws, size_t ws_size, hipStream_t stream) {
    static int grid = 0;
    if (grid == 0) {
        int dev = 0, cus = 0, per_cu = 0;
        if (n_in != 23 || ws_size < WS_END) { fprintf(stderr, "kernel_launch: unexpected n_in %d / ws %zu\n", n_in, ws_size); grid = -1; return; }
        hipGetDevice(&dev); hipDeviceGetAttribute(&cus, hipDeviceAttributeMultiprocessorCount, dev);
        if (hipFuncSetAttribute((const void*)yoco_fwd, hipFuncAttributeMaxDynamicSharedMemorySize, LDS_BYTES) != hipSuccess) { fprintf(stderr, "kernel_launch: hipFuncSetAttribute failed\n"); grid = -1; return; }
        if (hipOccupancyMaxActiveBlocksPerMultiprocessor(&per_cu, (const void*)yoco_fwd, 512, LDS_BYTES) != hipSuccess || per_cu < 1) { fprintf(stderr, "kernel_launch: occupancy query says %d blocks per CU\n", per_cu); per_cu = 1; }
        (void)hipGetLastError();
        grid = cus;
    }
    if (grid < 0) return;
    Params p{};
    for (int i = 0; i < 23; ++i) p.in[i] = (const float*)d_in[i];
    p.out = (float*)d_out; p.ws = (unsigned char*)d_ws;
    if (hipMemsetAsync((char*)d_ws + WS_BAR, 0, 65536, stream) != hipSuccess) { fprintf(stderr, "kernel_launch: memset of the control words failed\n"); return; }
#if N_LAUNCHES == 1
    p.ph_lo = 0; p.ph_hi = NPHASE;
    void* args[] = {&p};
    hipError_t e = hipLaunchCooperativeKernel((const void*)yoco_fwd, dim3(grid), dim3(512), args, LDS_BYTES, stream);
    if (e != hipSuccess) fprintf(stderr, "cooperative launch failed: %s (grid %d)\n", hipGetErrorString(e), grid);
#else
    for (int ph = 0; ph < NPHASE; ++ph) { p.ph_lo = ph; p.ph_hi = ph + 1; hipLaunchKernelGGL(yoco_fwd, dim3(grid), dim3(512), LDS_BYTES, stream, p); }
#endif
}
```

```cpp
#include <hip/hip_runtime.h>
#include <hip/hip_cooperative_groups.h>
#include <cstdio>
#include <cstdint>
namespace cg = cooperative_groups;


__device__ __forceinline__ int opq_tid() { int t = threadIdx.x; asm volatile("" : "+v"(t)); return t; }
#ifndef REP2
#define REP2 1
#endif
#ifndef REP7
#define REP7 1
#endif
#ifndef REP0
#define REP0 1
#endif
#ifndef REP4
#define REP4 1
#endif
#ifndef REP7A
#define REP7A 1
#endif
#ifndef REP7B
#define REP7B 1
#endif
#ifndef REP7C
#define REP7C 1
#endif
#ifndef REPS
#define REPS 1
#endif
#ifndef REP1
#define REP1 1
#endif
#ifndef REP6
#define REP6 1
#endif
#ifndef N_LAUNCHES
#define N_LAUNCHES 1
#endif

namespace pg8 {
#define PG8_LAS __attribute__((address_space(3)))
typedef unsigned short bf16_t;
typedef short bf16x8 __attribute__((ext_vector_type(8)));
typedef float f32x4 __attribute__((ext_vector_type(4)));
typedef unsigned u32x4 __attribute__((ext_vector_type(4)));
constexpr int BM = 256, BK = 64, HALF = 128, HTB = HALF * BK * 2  , STAGE_BYTES = 8 * HTB, NXCD = 8, WGM = 8;

__host__ __device__ __forceinline__ int lds_byte(int r, int c) { const int st = (r >> 4) * 2 + (c >> 5), rr = r & 15, cc = c & 31, ob = rr * 64 + cc * 2; return st * 1024 + (ob ^ (((ob >> 9) & 1) << 5)); }
__host__ __device__ __forceinline__ void stage_rc(int b, int& R, int& C) { const int st = b / 1024, sb = b % 1024, swz = sb ^ (((sb >> 9) & 1) << 5); R = (st >> 1) * 16 + swz / 64; C = (st & 1) * 32 + (swz % 64) / 2; }
__host__ __device__ __forceinline__ int perm32(int rho) { const int n = rho >> 4, i = rho & 15; return 8 * (i >> 2) + 4 * n + (i & 3); }

struct Unit { int pm, pn; };
struct Gemm { const bf16_t* A; const bf16_t* Bt; int M, N, K; };

struct StaticOrder {
    int nM, nN, nwg, G, c;
    __host__ __device__ void init(int M, int N, int G_, int c_) { nM = M / BM; nN = N / BM; nwg = nM * nN; G = G_; c = c_; }
    __host__ __device__ bool next(int i, Unit& u) const {
        const long L = (long)i * G + c; if (L >= nwg) return false;
        int wgid = (int)L; { const int q = nwg / NXCD, r = nwg % NXCD, xcd = wgid % NXCD, off = wgid / NXCD; wgid = (xcd < r ? xcd * (q + 1) : r * (q + 1) + (xcd - r) * q) + off; }
        const int nig = WGM * nN, gid = wgid / nig, fm = gid * WGM, gsz = (nM - fm) < WGM ? (nM - fm) : WGM;
        u.pm = fm + ((wgid % nig) % gsz); u.pn = (wgid % nig) / gsz; return true;
    }
    __device__ __forceinline__ void a_ready(const Unit&) const {}
    __device__ __forceinline__ void done(const Unit&) const {}
};

typedef float f32x2 __attribute__((ext_vector_type(2)));
typedef __bf16 bf16x2v __attribute__((ext_vector_type(2)));
__device__ __forceinline__ unsigned cvt_pk_bf16(float lo, float hi) { const f32x2 f = {lo, hi}; return __builtin_bit_cast(unsigned, __builtin_convertvector(f, bf16x2v)); }
}
namespace pg8 {
template <class Epi, class Sched, bool ALIGN_EPI = false, bool SP2 = false>
__device__ __forceinline__ void gemm_phase(PG8_LAS unsigned char* lds, const Gemm g, const Sched& S, const Epi& E) {
    const int tid = opq_tid(), wid = __builtin_amdgcn_readfirstlane(tid >> 6), lane = tid & 63, wr = wid >> 2, wc = wid & 3, fr = lane & 15, fq = lane >> 4;
    const int K = g.K, nt = K / BK;
    unsigned voffA[2], voffB[2];
#pragma unroll
    for (int i = 0; i < 2; ++i) { int R, C; stage_rc(tid * 16 + i * 8192, R, C); const int Rb = Epi::PERM ? ((R & ~31) + perm32(R & 31)) : R;
        voffA[i] = (unsigned)(R * K + C) * 2u; voffB[i] = (unsigned)(Rb * K + C) * 2u; }
    const size_t kstep = (size_t)(BK * 2);
    const size_t hstep = (size_t)HALF * K * 2;
    const size_t tstep = 2 * hstep;
    const unsigned ldsw = (unsigned)wid * 1024u;
    const int aoff = lds_byte(wr * 64 + fr, fq * 8), boff = lds_byte(wc * 32 + fr, fq * 8);
#define PG8_SA(b, h) (((b) * 2 + (h)) * HTB)
#define PG8_SB(b, h) ((4 + (b) * 2 + (h)) * HTB)
#define PG8_STAGE(bufoff, gbase, voff) do { _Pragma("unroll") for (int _i = 0; _i < 2; ++_i) \
        __builtin_amdgcn_global_load_lds((const unsigned*)((const char*)(gbase) + (voff)[_i]), (PG8_LAS unsigned*)(lds + (bufoff) + ldsw + _i * 8192), 16, 0, 0); } while (0)
#define PG8_LDA(dst, b, h) do { _Pragma("unroll") for (int m = 0; m < 4; ++m) _Pragma("unroll") for (int k = 0; k < 2; ++k) dst[m][k] = *(const PG8_LAS bf16x8*)(lds + PG8_SA(b, h) + aoff + m * 2048 + k * 1024); } while (0)
#define PG8_LDB(dst, b, h) do { _Pragma("unroll") for (int n = 0; n < 2; ++n) _Pragma("unroll") for (int k = 0; k < 2; ++k) dst[n][k] = *(const PG8_LAS bf16x8*)(lds + PG8_SB(b, h) + boff + n * 2048 + k * 1024); } while (0)
#define PG8_MMA(ai, bj, At, Bt) do { __builtin_amdgcn_s_setprio(1); _Pragma("unroll") for (int m = 0; m < 4; ++m) _Pragma("unroll") for (int n = 0; n < 2; ++n) _Pragma("unroll") for (int k = 0; k < 2; ++k) \
        acc[ai][bj][m][n] = __builtin_amdgcn_mfma_f32_16x16x32_bf16(Bt[n][k], At[m][k], acc[ai][bj][m][n], 0, 0, 0); __builtin_amdgcn_s_setprio(0); } while (0)
#define PG8_WAIT_V(n) asm volatile("s_waitcnt vmcnt(" #n ")" ::: "memory")
#define PG8_WAIT_L(n) asm volatile("s_waitcnt lgkmcnt(" #n ")" ::: "memory")
#define PG8_BAR __builtin_amdgcn_s_barrier()
#define PG8_SCHED __builtin_amdgcn_sched_barrier(0)
    Unit cur, nxt; int ui = 0;
    if (!S.next(0, cur)) return;
    f32x4 acc[2][2][4][2];
#pragma unroll
    for (int a = 0; a < 2; ++a)
#pragma unroll
        for (int b = 0; b < 2; ++b)
#pragma unroll
            for (int m = 0; m < 4; ++m)
#pragma unroll
                for (int n = 0; n < 2; ++n) acc[a][b][m][n] = (f32x4){0.f, 0.f, 0.f, 0.f};
    bf16x8 At[4][2], B0[2][2], B1[2][2];
    const char* cA = (const char*)g.A + (size_t)cur.pm * tstep; const char* cB = (const char*)g.Bt + (size_t)cur.pn * tstep;
    S.a_ready(cur);
    if constexpr (SP2) {
        PG8_STAGE(PG8_SB(0, 0), cB, voffB); PG8_STAGE(PG8_SB(0, 1), cB + hstep, voffB); PG8_STAGE(PG8_SA(0, 0), cA, voffA); PG8_STAGE(PG8_SA(0, 1), cA + hstep, voffA);
        if (wr == 1) PG8_BAR;
        PG8_WAIT_V(2); PG8_BAR;
        PG8_STAGE(PG8_SB(1, 0), cB + kstep, voffB); PG8_STAGE(PG8_SA(1, 0), cA + kstep, voffA); PG8_STAGE(PG8_SB(1, 1), cB + hstep + kstep, voffB);
        PG8_WAIT_V(6); PG8_BAR;
    } else {
        PG8_STAGE(PG8_SB(0, 0), cB, voffB); PG8_STAGE(PG8_SA(0, 0), cA, voffA); PG8_STAGE(PG8_SB(0, 1), cB + hstep, voffB); PG8_STAGE(PG8_SA(0, 1), cA + hstep, voffA);
        if (wr == 1) PG8_BAR;
        PG8_WAIT_V(4); PG8_BAR;
        PG8_STAGE(PG8_SB(1, 0), cB + kstep, voffB); PG8_STAGE(PG8_SA(1, 0), cA + kstep, voffA); PG8_STAGE(PG8_SB(1, 1), cB + hstep + kstep, voffB);
        PG8_WAIT_V(6); PG8_BAR;
    }
    for (;;) {
        const bool has_next = S.next(ui + 1, nxt);
        const char* nA = has_next ? (const char*)g.A + (size_t)nxt.pm * tstep : cA; const char* nB = has_next ? (const char*)g.Bt + (size_t)nxt.pn * tstep : cB;
        for (int t = 0; t < nt; t += 2) {
            const bool last = (t == nt - 2);
            const char* a1 = cA + (size_t)(t + 1) * kstep;
            const char* a2 = last ? nA : cA + (size_t)(t + 2) * kstep; const char* b2 = last ? nB : cB + (size_t)(t + 2) * kstep;
            const char* a3 = a2 + kstep; const char* b3 = b2 + kstep;
            if (last && has_next) S.a_ready(nxt);
            if constexpr (SP2) {
            PG8_LDB(B0, 0, 0); PG8_LDB(B1, 0, 1); PG8_SCHED; PG8_LDA(At, 0, 0); PG8_STAGE(PG8_SA(1, 1), a1 + hstep, voffA);
            PG8_WAIT_V(8); PG8_WAIT_L(0); PG8_BAR; PG8_MMA(0, 0, At, B0); PG8_MMA(0, 1, At, B1); PG8_BAR; PG8_SCHED;
            PG8_LDA(At, 0, 1); PG8_STAGE(PG8_SB(0, 0), b2, voffB); PG8_STAGE(PG8_SB(0, 1), b2 + hstep, voffB); PG8_STAGE(PG8_SA(0, 0), a2, voffA);
            PG8_WAIT_V(8); PG8_WAIT_L(0); PG8_BAR; PG8_MMA(1, 0, At, B0); PG8_MMA(1, 1, At, B1); PG8_BAR; PG8_SCHED;
            PG8_LDB(B0, 1, 0); PG8_LDB(B1, 1, 1); PG8_SCHED; PG8_LDA(At, 1, 0); PG8_STAGE(PG8_SA(0, 1), a2 + hstep, voffA);
            PG8_WAIT_V(8); PG8_WAIT_L(0); PG8_BAR; PG8_MMA(0, 0, At, B0); PG8_MMA(0, 1, At, B1); PG8_BAR; PG8_SCHED;
            PG8_LDA(At, 1, 1); PG8_STAGE(PG8_SB(1, 0), b3, voffB); PG8_STAGE(PG8_SB(1, 1), b3 + hstep, voffB); PG8_STAGE(PG8_SA(1, 0), a3, voffA);
            PG8_WAIT_V(8); PG8_WAIT_L(0); PG8_BAR; PG8_MMA(1, 0, At, B0); PG8_MMA(1, 1, At, B1); PG8_BAR; PG8_SCHED;
            } else {
            PG8_LDB(B0, 0, 0); PG8_SCHED; PG8_LDA(At, 0, 0); PG8_STAGE(PG8_SA(1, 1), a1 + hstep, voffA);
            PG8_WAIT_L(8); PG8_BAR; PG8_WAIT_L(0); PG8_MMA(0, 0, At, B0); PG8_BAR; PG8_SCHED;
            PG8_LDB(B1, 0, 1); PG8_STAGE(PG8_SB(0, 0), b2, voffB);
            PG8_BAR; PG8_WAIT_L(0); PG8_MMA(0, 1, At, B1); PG8_BAR;
            PG8_LDA(At, 0, 1); PG8_STAGE(PG8_SA(0, 0), a2, voffA);
            PG8_BAR; PG8_WAIT_L(0); PG8_MMA(1, 0, At, B0); PG8_BAR; PG8_SCHED;
            PG8_STAGE(PG8_SB(0, 1), b2 + hstep, voffB);
            PG8_WAIT_V(6); PG8_BAR; PG8_MMA(1, 1, At, B1); PG8_BAR;
            PG8_LDB(B0, 1, 0); PG8_SCHED; PG8_LDA(At, 1, 0); PG8_STAGE(PG8_SA(0, 1), a2 + hstep, voffA);
            PG8_WAIT_L(8); PG8_BAR; PG8_WAIT_L(0); PG8_MMA(0, 0, At, B0); PG8_BAR; PG8_SCHED;
            PG8_LDB(B1, 1, 1); PG8_STAGE(PG8_SB(1, 0), b3, voffB);
            PG8_BAR; PG8_WAIT_L(0); PG8_MMA(0, 1, At, B1); PG8_BAR;
            PG8_LDA(At, 1, 1); PG8_STAGE(PG8_SA(1, 0), a3, voffA);
            PG8_BAR; PG8_WAIT_L(0); PG8_MMA(1, 0, At, B0); PG8_BAR; PG8_SCHED;
            PG8_STAGE(PG8_SB(1, 1), b3 + hstep, voffB);
            PG8_WAIT_V(6); PG8_BAR; PG8_MMA(1, 1, At, B1); PG8_BAR;
            }
        }
        if constexpr (ALIGN_EPI) { if (wr == 0) PG8_BAR; }
        if constexpr (!Epi::AFTER_DRAIN) { E(acc, cur, wr, wc, fr, fq); S.done(cur); }
        if (!has_next) break;
#pragma unroll
        for (int a = 0; a < 2; ++a)
#pragma unroll
            for (int b = 0; b < 2; ++b)
#pragma unroll
                for (int m = 0; m < 4; ++m)
#pragma unroll
                    for (int n = 0; n < 2; ++n) acc[a][b][m][n] = (f32x4){0.f, 0.f, 0.f, 0.f};
        cur = nxt; cA = nA; cB = nB; ++ui;
        if constexpr (ALIGN_EPI) { if (wr == 1) PG8_BAR; }
    }
    PG8_WAIT_V(0);
    if constexpr (!ALIGN_EPI) { if (wr == 0) PG8_BAR; }
    PG8_BAR;
    if constexpr (Epi::AFTER_DRAIN) { E.fused(acc, cur, wr, wc, fr, fq, lds, wid, lane); S.done(cur); }
#undef PG8_SA
#undef PG8_SB
#undef PG8_STAGE
#undef PG8_LDA
#undef PG8_LDB
#undef PG8_MMA
#undef PG8_WAIT_V
#undef PG8_WAIT_L
#undef PG8_BAR
#undef PG8_SCHED
}
}

#define LAS __attribute__((address_space(3)))
using pg8::bf16_t; using pg8::bf16x8; using pg8::f32x4; using pg8::u32x4; using pg8::cvt_pk_bf16;
typedef short s16x4 __attribute__((ext_vector_type(4)));
typedef unsigned u32x2 __attribute__((ext_vector_type(2)));
typedef LAS s16x4 lds_s16x4;

constexpr int DM = 1024, NP = 16384, NS = 256, NR = NP + NS, FF = 4096, NPHASE = 12;
constexpr float EPS = 1e-6f;
constexpr int LDS_BYTES = 131072 + 256 + 1024;
constexpr size_t MB = 1024 * 1024;
constexpr size_t WS_BAR = 768 * 1024;
constexpr size_t WS_Q = 768 * 1024 + 16384;
constexpr size_t WS_SS = 0;
constexpr size_t WS_WIN0 = 1 * MB, WS_WINKV1 = 3 * MB, WS_WOUT0 = 7 * MB, WS_WOUT1 = 9 * MB, WS_WMEM0 = 11 * MB, WS_WMEM1 = 13 * MB,
                 WS_WFF1_0 = 15 * MB, WS_WFF1_1 = 23 * MB, WS_WFF2_0 = 31 * MB, WS_WFF2_1 = 39 * MB, WS_WPOOL = 47 * MB;
constexpr size_t WS_XB = 48 * MB, WS_MEMB = 81 * MB, WS_R = 82 * MB, WS_Z = WS_R, WS_MIX = WS_R + 33 * MB, WS_HID = WS_R, WS_KB = WS_R + 66 * MB, WS_VB = WS_R + 83 * MB, WS_END = WS_R + 131 * MB;
constexpr size_t O_Y = 0, O_MEMK = 17039360, O_MEMV = 17563648, O_POOLP = 18087936, O_KP = 18103296, O_VP = 26491904, O_POOLS = 34880512, O_KS = 34941952, O_VS = 35073024;

constexpr size_t SKB_ROWS = 2112;
constexpr size_t Y_SKB = 0, Y_SVB = Y_SKB + 8 * SKB_ROWS * 512, Y_MKB = Y_SVB + 8 * SKB_ROWS * 512, Y_MVB = Y_MKB + 2 * 10 * 256 * 512, Y_END = Y_MVB + 2 * 10 * 256 * 512;
static_assert(Y_END * 2 <= (size_t)NP * DM * 4, "scratch must fit the y_prompt region");
struct Params { const float* in[23]; float* out; unsigned char* ws; int ph_lo, ph_hi; };

#define MFMA16(a, b, c) __builtin_amdgcn_mfma_f32_16x16x32_bf16((a), (b), (c), 0, 0, 0)
__device__ __forceinline__ void st_bf16x4(bf16_t* p, f32x4 v) { u32x2 w; w.x = cvt_pk_bf16(v[0], v[1]); w.y = cvt_pk_bf16(v[2], v[3]); *(u32x2*)p = w; }
__device__ __forceinline__ float wave_sum(float v) {
#pragma unroll
    for (int o = 1; o < 64; o <<= 1) v += __shfl_xor(v, o);
    return v;
}

typedef unsigned long long ss_t;
__device__ __forceinline__ ss_t ss_fix(float s) { return (ss_t)(s * 1048576.f + 0.5f); }
__device__ __forceinline__ float ss_rs(ss_t v) { return rsqrtf((float)v * (1.f / (1024.f * 1048576.f)) + EPS); }
struct FZ0 {
    static constexpr bool NEED_SS = false, HAS_PRE = false;
    const ss_t* ss; bf16_t* z; float* pool_p; float* pool_s; const LAS float* rst;
    __device__ __forceinline__ float rowscale(int row) const { return ss_rs(ss[row]); }
    __device__ __forceinline__ float store(int row, int col, f32x4 v, float rs) const {
        v = v * rs; st_bf16x4(z + (size_t)row * DM + col, col < 512 ? v : v * (0.08838834764831845f * 1.4426950408889634f));
        if (col < 512) {
            if (row < NP) { const int t = row & 8191; if (t >= 8177) *(f32x4*)(pool_p + (size_t)((row >> 13) * 15 + (t - 8177)) * 512 + col) = v; }
            else { const int r = row - NP, t = r & 31; if (t >= 17) *(f32x4*)(pool_s + (size_t)((r >> 5) * 15 + (t - 17)) * 512 + col) = v; }
        }
        return 0.f;
    }
    __device__ __forceinline__ float store8(int row, int col, f32x4 v0, f32x4 v1, float rs) const {
        v0 = v0 * rs; v1 = v1 * rs;
        if (col < 512) {
            if (row < NP) { const int t = row & 8191; if (t >= 8177) { float* pp = pool_p + (size_t)((row >> 13) * 15 + (t - 8177)) * 512 + col; *(f32x4*)pp = v0; *(f32x4*)(pp + 4) = v1; } }
        } else { v0 = v0 * (0.08838834764831845f * 1.4426950408889634f); v1 = v1 * (0.08838834764831845f * 1.4426950408889634f); }
        u32x4 w; w.x = cvt_pk_bf16(v0[0], v0[1]); w.y = cvt_pk_bf16(v0[2], v0[3]); w.z = cvt_pk_bf16(v1[0], v1[1]); w.w = cvt_pk_bf16(v1[2], v1[3]);
        *(u32x4*)(z + (size_t)row * DM + col) = w; return 0.f;
    }
    __device__ __forceinline__ void rowdone(int, float) const {}
};
struct FMemKV {
    static constexpr bool NEED_SS = false, HAS_PRE = false;
    const ss_t* ss; float* mk; float* mv; bf16_t* mkb; bf16_t* mvb;
    __device__ __forceinline__ float rowscale(int row) const { return ss_rs(ss[row]); }
    __device__ __forceinline__ float store(int row, int col, f32x4 v, float rs) const {
        v = v * rs; const int l = col >> 10, c = col & 1023; const size_t fo = (size_t)l * 512 * 512 + (size_t)row * 512, bo = (size_t)l * 10 * 256 * 512 + (size_t)row * 512;
        if (c < 512) { *(f32x4*)(mk + fo + c) = v; st_bf16x4(mkb + bo + c, v); } else { *(f32x4*)(mv + fo + (c - 512)) = v; st_bf16x4(mvb + bo + (c - 512), v); } return 0.f;
    }
    __device__ __forceinline__ void rowdone(int, float) const {}
};
struct FRes {
    static constexpr bool NEED_SS = true, HAS_PRE = true;
    float* xres; bf16_t* xb_in; bf16_t* xb; ss_t* ss_out; const LAS float* rst;
    __device__ __forceinline__ float rowscale(int) const { return 1.f; }
    __device__ __forceinline__ float store(int row, int col, f32x4 v, float) const {
        const u32x2 w = *(const u32x2*)(xb_in + (size_t)row * DM + col);
        const f32x4 x = (f32x4){__uint_as_float(w.x << 16), __uint_as_float(w.x & 0xffff0000u), __uint_as_float(w.y << 16), __uint_as_float(w.y & 0xffff0000u)} + v;
        if (xres) *(f32x4*)(xres + (size_t)row * DM + col) = x;
        if (xb) st_bf16x4(xb + (size_t)row * DM + col, x);
        return (x[0] * x[0] + x[1] * x[1]) + (x[2] * x[2] + x[3] * x[3]);
    }
    __device__ __forceinline__ u32x2 pre4(int row, int col) const { return *(const u32x2*)(xb_in + (size_t)row * DM + col); }
    __device__ __forceinline__ float fin4(int row, int col, f32x4 v, u32x2 w) const {
        const f32x4 x = (f32x4){__uint_as_float(w.x << 16), __uint_as_float(w.x & 0xffff0000u), __uint_as_float(w.y << 16), __uint_as_float(w.y & 0xffff0000u)} + v;
        if (xres) *(f32x4*)(xres + (size_t)row * DM + col) = x;
        if (xb) st_bf16x4(xb + (size_t)row * DM + col, x);
        return (x[0] * x[0] + x[1] * x[1]) + (x[2] * x[2] + x[3] * x[3]);
    }
    __device__ __forceinline__ u32x4 pre8(int row, int col) const { return *(const u32x4*)(xb_in + (size_t)row * DM + col); }
    __device__ __forceinline__ float fin8(int row, int col, f32x4 v0, f32x4 v1, u32x4 w) const {
        const f32x4 x0 = (f32x4){__uint_as_float(w.x << 16), __uint_as_float(w.x & 0xffff0000u), __uint_as_float(w.y << 16), __uint_as_float(w.y & 0xffff0000u)} + v0;
        const f32x4 x1 = (f32x4){__uint_as_float(w.z << 16), __uint_as_float(w.z & 0xffff0000u), __uint_as_float(w.w << 16), __uint_as_float(w.w & 0xffff0000u)} + v1;
        if (xres) { float* xp = xres + (size_t)row * DM + col; *(f32x4*)xp = x0; *(f32x4*)(xp + 4) = x1; }
        if (xb) { u32x4 o; o.x = cvt_pk_bf16(x0[0], x0[1]); o.y = cvt_pk_bf16(x0[2], x0[3]); o.z = cvt_pk_bf16(x1[0], x1[1]); o.w = cvt_pk_bf16(x1[2], x1[3]); *(u32x4*)(xb + (size_t)row * DM + col) = o; }
        return ((x0[0] * x0[0] + x0[1] * x0[1]) + (x0[2] * x0[2] + x0[3] * x0[3])) + ((x1[0] * x1[0] + x1[1] * x1[1]) + (x1[2] * x1[2] + x1[3] * x1[3]));
    }
    __device__ __forceinline__ void rowdone(int row, float s) const { if (ss_out) atomicAdd(ss_out + row, ss_fix(s)); }
};
struct FFfn1 {
    static constexpr bool NEED_SS = false, HAS_PRE = false;
    const ss_t* ss; bf16_t* hid; const LAS float* rst;
    __device__ __forceinline__ float rowscale(int row) const { return ss_rs(ss[row]); }
    __device__ __forceinline__ float store(int row, int col, f32x4 v, float rs) const {
        v = v * rs; v = __builtin_elementwise_max(v, (f32x4){0.f, 0.f, 0.f, 0.f}); v = v * v; st_bf16x4(hid + (size_t)row * FF + col, v); return 0.f;
    }
    __device__ __forceinline__ float store8(int row, int col, f32x4 v0, f32x4 v1, float rs) const {
        const f32x4 zz = {0.f, 0.f, 0.f, 0.f}; v0 = __builtin_elementwise_max(v0 * rs, zz); v1 = __builtin_elementwise_max(v1 * rs, zz); v0 = v0 * v0; v1 = v1 * v1;
        u32x4 w; w.x = cvt_pk_bf16(v0[0], v0[1]); w.y = cvt_pk_bf16(v0[2], v0[3]); w.z = cvt_pk_bf16(v1[0], v1[1]); w.w = cvt_pk_bf16(v1[2], v1[3]);
        *(u32x4*)(hid + (size_t)row * FF + col) = w; return 0.f;
    }
    __device__ __forceinline__ void rowdone(int, float) const {}
};
struct FZkv {
    static constexpr bool NEED_SS = false, HAS_PRE = false;
    const ss_t* ss; bf16_t* z; float* out; bf16_t* kb; bf16_t* vb; bf16_t* skb; bf16_t* svb; const LAS float* rst;
    __device__ __forceinline__ float rowscale(int row) const { return ss_rs(ss[row]); }
    __device__ __forceinline__ float store(int row, int col, f32x4 v, float rs) const {
        v = v * rs;
        if (col < 1024) st_bf16x4(z + (size_t)row * DM + col, v * (col < 512 ? (0.125f * 1.4426950408889634f) : (0.08838834764831845f * 1.4426950408889634f)));
        else { const int c = col - 1024; const bool smp = row >= NP, isv = c >= 512; const int r = smp ? row - NP : row;
            size_t off = smp ? (isv ? O_VS : O_KS) : (isv ? O_VP : O_KP); off += (size_t)r * 512 + (c & 511);
            *(f32x4*)(out + off) = v;
            if (!smp) st_bf16x4((isv ? vb : kb) + (size_t)r * 512 + (c & 511), v);
            else st_bf16x4((isv ? svb : skb) + ((size_t)(r >> 5) * SKB_ROWS + 2048 + (r & 31)) * 512 + (c & 511), v); }
        return 0.f;
    }
    __device__ __forceinline__ float store8(int row, int col, f32x4 v0, f32x4 v1, float rs) const {
        v0 = v0 * rs; v1 = v1 * rs;
        if (col < 1024) { const float sc = col < 512 ? (0.125f * 1.4426950408889634f) : (0.08838834764831845f * 1.4426950408889634f); v0 = v0 * sc; v1 = v1 * sc;
            u32x4 w; w.x = cvt_pk_bf16(v0[0], v0[1]); w.y = cvt_pk_bf16(v0[2], v0[3]); w.z = cvt_pk_bf16(v1[0], v1[1]); w.w = cvt_pk_bf16(v1[2], v1[3]); *(u32x4*)(z + (size_t)row * DM + col) = w; }
        else { const int c = col - 1024; const bool isv = c >= 512; float* op = out + (isv ? O_VP : O_KP) + (size_t)row * 512 + (c & 511); *(f32x4*)op = v0; *(f32x4*)(op + 4) = v1;
            u32x4 w; w.x = cvt_pk_bf16(v0[0], v0[1]); w.y = cvt_pk_bf16(v0[2], v0[3]); w.z = cvt_pk_bf16(v1[0], v1[1]); w.w = cvt_pk_bf16(v1[2], v1[3]); *(u32x4*)((isv ? vb : kb) + (size_t)row * 512 + (c & 511)) = w; }
        return 0.f;
    }
    __device__ __forceinline__ void rowdone(int, float) const {}
};

namespace pg8 {
template <class F> struct EpiF {
    static constexpr bool PERM = false, AFTER_DRAIN = false;
    F f;
    __device__ __forceinline__ void operator()(const f32x4 (&acc)[2][2][4][2], const Unit& u, int wr, int wc, int fr, int fq) const {
#pragma unroll
        for (int ai = 0; ai < 2; ++ai)
#pragma unroll
            for (int m = 0; m < 4; ++m) {
                const int row = u.pm * BM + ai * HALF + wr * 64 + m * 16 + fr;
                const float rs = f.rowscale(row); float ssq = 0.f;
#pragma unroll
                for (int bj = 0; bj < 2; ++bj)
#pragma unroll
                    for (int n = 0; n < 2; ++n) ssq += f.store(row, u.pn * BM + bj * HALF + wc * 32 + n * 16 + 4 * fq, acc[ai][bj][m][n], rs);
                if (F::NEED_SS) { ssq += __shfl_xor(ssq, 16); ssq += __shfl_xor(ssq, 32); if (fq == 0) f.rowdone(row, ssq); }
            }
    }
};
template <class F> struct EpiF8 {
    static constexpr bool PERM = true, AFTER_DRAIN = false;
    F f;
    __device__ __forceinline__ void operator()(const f32x4 (&acc)[2][2][4][2], const Unit& u, int wr, int wc, int fr, int fq) const {
        float rsv[2][4], ssv[2][4];
#pragma unroll
        for (int ai = 0; ai < 2; ++ai)
#pragma unroll
            for (int m = 0; m < 4; ++m) rsv[ai][m] = f.rst ? f.rst[ai * HALF + wr * 64 + m * 16 + fr] : f.rowscale(u.pm * BM + ai * HALF + wr * 64 + m * 16 + fr);
#pragma unroll
        for (int ai = 0; ai < 2; ++ai) {
            u32x4 pre[4][2];
#pragma unroll
            for (int m = 0; m < 4; ++m)
#pragma unroll
                for (int bj = 0; bj < 2; ++bj) { if constexpr (F::HAS_PRE) pre[m][bj] = f.pre8(u.pm * BM + ai * HALF + wr * 64 + m * 16 + fr, u.pn * BM + bj * HALF + wc * 32 + 8 * fq); else pre[m][bj] = (u32x4){0u, 0u, 0u, 0u}; }
            __builtin_amdgcn_sched_barrier(0);
#pragma unroll
            for (int m = 0; m < 4; ++m) {
                const int row = u.pm * BM + ai * HALF + wr * 64 + m * 16 + fr;
                float ssq = 0.f;
#pragma unroll
                for (int bj = 0; bj < 2; ++bj) { const int col = u.pn * BM + bj * HALF + wc * 32 + 8 * fq;
                    if constexpr (F::HAS_PRE) ssq += f.fin8(row, col, acc[ai][bj][m][0], acc[ai][bj][m][1], pre[m][bj]);
                    else ssq += f.store8(row, col, acc[ai][bj][m][0], acc[ai][bj][m][1], rsv[ai][m]); }
                if (F::NEED_SS) { ssq += __shfl_xor(ssq, 16); ssq += __shfl_xor(ssq, 32); ssv[ai][m] = ssq; }
            }
        }
        if (F::NEED_SS) {
#pragma unroll
            for (int ai = 0; ai < 2; ++ai)
#pragma unroll
                for (int m = 0; m < 4; ++m) if (fq == 0) f.rowdone(u.pm * BM + ai * HALF + wr * 64 + m * 16 + fr, ssv[ai][m]);
        }
    }
};
struct EpiFinal {
    static constexpr bool PERM = true, AFTER_DRAIN = true;
    const bf16_t* xb; float* y; const float* g; ss_t* ss; unsigned* cnt;
    __device__ __forceinline__ void fused(f32x4 (&acc)[2][2][4][2], const Unit& u, int wr, int wc, int fr, int fq, PG8_LAS unsigned char*, int, int) const {
#pragma unroll
        for (int ai = 0; ai < 2; ++ai) {
            u32x2 pre[4][2][2];
#pragma unroll
            for (int m = 0; m < 4; ++m)
#pragma unroll
                for (int bj = 0; bj < 2; ++bj)
#pragma unroll
                    for (int n = 0; n < 2; ++n) pre[m][bj][n] = *(const u32x2*)(xb + (size_t)(u.pm * BM + ai * HALF + wr * 64 + m * 16 + fr) * DM + u.pn * BM + bj * HALF + wc * 32 + 8 * fq + 4 * n);
            __builtin_amdgcn_sched_barrier(0);
#pragma unroll
            for (int m = 0; m < 4; ++m) {
                const int row = u.pm * BM + ai * HALF + wr * 64 + m * 16 + fr; float ssq = 0.f;
#pragma unroll
                for (int bj = 0; bj < 2; ++bj)
#pragma unroll
                    for (int n = 0; n < 2; ++n) { const int col = u.pn * BM + bj * HALF + wc * 32 + 8 * fq + 4 * n;
                        const u32x2 w = pre[m][bj][n];
                        const f32x4 x = (f32x4){__uint_as_float(w.x << 16), __uint_as_float(w.x & 0xffff0000u), __uint_as_float(w.y << 16), __uint_as_float(w.y & 0xffff0000u)} + acc[ai][bj][m][n];
                        acc[ai][bj][m][n] = x; ssq += (x[0] * x[0] + x[1] * x[1]) + (x[2] * x[2] + x[3] * x[3]); }
                ssq += __shfl_xor(ssq, 16); ssq += __shfl_xor(ssq, 32);
                if (fq == 0) atomicAdd(ss + row, ss_fix(ssq));
            }
        }
        asm volatile("s_waitcnt vmcnt(0)" ::: "memory");
        __syncthreads();
        if (threadIdx.x == 0) {
            __hip_atomic_fetch_add(cnt + 64 * u.pm, 1u, __ATOMIC_RELAXED, __HIP_MEMORY_SCOPE_AGENT);
            while (__hip_atomic_load(cnt + 64 * u.pm, __ATOMIC_RELAXED, __HIP_MEMORY_SCOPE_AGENT) < 4u) __builtin_amdgcn_s_sleep(2);
        }
        __syncthreads();
        ss_t tot[2][4]; f32x4 gv[2][2];
#pragma unroll
        for (int ai = 0; ai < 2; ++ai)
#pragma unroll
            for (int m = 0; m < 4; ++m) tot[ai][m] = __hip_atomic_load(ss + (u.pm * BM + ai * HALF + wr * 64 + m * 16 + fr), __ATOMIC_RELAXED, __HIP_MEMORY_SCOPE_AGENT);
#pragma unroll
        for (int bj = 0; bj < 2; ++bj)
#pragma unroll
            for (int n = 0; n < 2; ++n) gv[bj][n] = *(const f32x4*)(g + u.pn * BM + bj * HALF + wc * 32 + 8 * fq + 4 * n);
        __builtin_amdgcn_sched_barrier(0);
#pragma unroll
        for (int ai = 0; ai < 2; ++ai)
#pragma unroll
            for (int m = 0; m < 4; ++m) {
                const int row = u.pm * BM + ai * HALF + wr * 64 + m * 16 + fr;
                const float rs = ss_rs(tot[ai][m]);
#pragma unroll
                for (int bj = 0; bj < 2; ++bj)
#pragma unroll
                    for (int n = 0; n < 2; ++n) { const int col = u.pn * BM + bj * HALF + wc * 32 + 8 * fq + 4 * n;
                        *(f32x4*)(y + (size_t)row * DM + col) = acc[ai][bj][m][n] * rs * gv[bj][n]; }
            }
    }
};
}

__device__ __forceinline__ bool static_unit(int M, int N, int G, int c, int i, int& pm, int& pn) {
    const int nM = M / 256, nN = N / 256, nwg = nM * nN; const long L = (long)i * G + c; if (L >= nwg) return false;
    int wgid = (int)L; { const int q = nwg / 8, r = nwg % 8, xcd = wgid % 8, off = wgid / 8; wgid = (xcd < r ? xcd * (q + 1) : r * (q + 1) + (xcd - r) * q) + off; }
    const int nig = 8 * nN, gid = wgid / nig, fm = gid * 8, gsz = (nM - fm) < 8 ? (nM - fm) : 8;
    pm = fm + ((wgid % nig) % gsz); pn = (wgid % nig) / gsz; return true;
}
template <class F>
__device__ __forceinline__ void big_gemm8(LAS unsigned char* lds, const bf16_t* A, const bf16_t* Bt, int N, int K, F f) {
    pg8::Gemm g{A, Bt, NP, N, K}; pg8::StaticOrder S; S.init(NP, N, (int)gridDim.x, (int)blockIdx.x);
    f.rst = nullptr;
    if (F::NEED_SS == false && gridDim.x == 256) { pg8::Unit u0; if (S.next(0, u0)) { LAS float* t = (LAS float*)(lds + 131072 + 256); const int tid = opq_tid(); if (tid < 256) t[tid] = f.rowscale(u0.pm * 256 + tid); f.rst = t; } __syncthreads(); }
    pg8::EpiF8<F> E{f};
    pg8::gemm_phase<pg8::EpiF8<F>, pg8::StaticOrder, true, true>(lds, g, S, E);
}
template <class F>
__device__ __forceinline__ void big_gemm(LAS unsigned char* lds, const bf16_t* A, const bf16_t* Bt, int N, int K, const F& f) {
    pg8::Gemm g{A, Bt, NP, N, K}; pg8::StaticOrder S; S.init(NP, N, (int)gridDim.x, (int)blockIdx.x);
    pg8::EpiF<F> E{f};
    pg8::gemm_phase<pg8::EpiF<F>, pg8::StaticOrder, true, true>(lds, g, S, E);
}

template <int RI, int CJ, class F>
__device__ __forceinline__ void small_gemm(LAS unsigned char* lds, const bf16_t* A, const bf16_t* Bt, int K, int nrt, int nct, int row_base, const F& f, int first_block = 0) {
    const int tid = opq_tid(), wid = __builtin_amdgcn_readfirstlane(tid >> 6), lane = tid & 63, fr = lane & 15, fq = lane >> 4;
    const int kw = K >> 3;
    LAS f32x4* red = (LAS f32x4*)lds;
    for (int it = ((int)blockIdx.x - first_block + (int)gridDim.x) % (int)gridDim.x; it < nrt * nct; it += gridDim.x) {
        const int rt = it % nrt, ct = it / nrt;
        const bf16_t* ap = A + (size_t)(rt * 16 * RI + fr) * K + wid * kw + fq * 8;
        const bf16_t* bp = Bt + (size_t)(ct * 16 * CJ + fr) * K + wid * kw + fq * 8;
        constexpr int NSL = (RI * CJ * 64 + 511) / 512;
        float rsv[NSL]; u32x2 prer[NSL];
#pragma unroll
        for (int h = 0; h < NSL; ++h) { const int slot = tid + 512 * h; rsv[h] = 1.f; prer[h] = (u32x2){0u, 0u};
            if (slot < RI * CJ * 64) { const int ij_ = slot >> 6, row_ = row_base + rt * 16 * RI + (ij_ / CJ) * 16 + fr; rsv[h] = f.rowscale(row_);
                if constexpr (F::HAS_PRE) prer[h] = f.pre4(row_, ct * 16 * CJ + (ij_ % CJ) * 16 + 4 * fq); } }
        f32x4 acc[RI][CJ];
#pragma unroll
        for (int i = 0; i < RI; ++i)
#pragma unroll
            for (int j = 0; j < CJ; ++j) acc[i][j] = (f32x4){0.f, 0.f, 0.f, 0.f};
        for (int k = 0; k < kw; k += 128) {
            bf16x8 x[4][RI], y[4][CJ];
#pragma unroll
            for (int kk = 0; kk < 4; ++kk) {
#pragma unroll
                for (int i = 0; i < RI; ++i) x[kk][i] = *(const bf16x8*)(ap + (size_t)i * 16 * K + k + kk * 32);
#pragma unroll
                for (int j = 0; j < CJ; ++j) y[kk][j] = *(const bf16x8*)(bp + (size_t)j * 16 * K + k + kk * 32); }
#pragma unroll
            for (int kk = 0; kk < 4; ++kk)
#pragma unroll
                for (int i = 0; i < RI; ++i)
#pragma unroll
                    for (int j = 0; j < CJ; ++j) acc[i][j] = MFMA16(y[kk][j], x[kk][i], acc[i][j]);
        }
#pragma unroll
        for (int i = 0; i < RI; ++i)
#pragma unroll
            for (int j = 0; j < CJ; ++j) red[(wid * RI * CJ + i * CJ + j) * 64 + lane] = acc[i][j];
        __syncthreads();
#pragma unroll
        for (int h = 0; h < NSL; ++h) { const int slot = tid + 512 * h; if (slot >= RI * CJ * 64) break;
            const int ij = slot >> 6; f32x4 sacc = red[ij * 64 + lane];
#pragma unroll
            for (int w = 1; w < 8; ++w) sacc = sacc + red[(w * RI * CJ + ij) * 64 + lane];
            const int row = row_base + rt * 16 * RI + (ij / CJ) * 16 + fr, col = ct * 16 * CJ + (ij % CJ) * 16 + 4 * fq;
            float q; if constexpr (F::HAS_PRE) q = f.fin4(row, col, sacc, prer[h]); else q = f.store(row, col, sacc, rsv[h]);
            if (F::NEED_SS) f.rowdone(row, q);
        }
        __syncthreads();
    }
}

__device__ __forceinline__ void transpose_item(const float* W, int K, int N, const float* gk, const float* gn, bf16_t* WT, int row_off, LAS float* scr, int item, int lane) {
    const int nblk = N / 32, kb = item / nblk, nb = item % nblk, k0 = 64 * kb, n0 = 32 * nb;
    const int kr = lane >> 3, n4 = (lane & 7) * 4;
    const f32x4 cn = gn ? *(const f32x4*)(gn + n0 + n4) : (f32x4){1.f, 1.f, 1.f, 1.f};
    f32x4 v[8];
#pragma unroll
    for (int i = 0; i < 8; ++i) v[i] = __builtin_nontemporal_load((const f32x4*)(W + (size_t)(k0 + 8 * i + kr) * N + n0 + n4));
#pragma unroll
    for (int i = 0; i < 8; ++i) { const int kk = 8 * i + kr; f32x4 x = v[i] * cn; if (gk) x = x * gk[k0 + kk];
        scr[kk * 33 + n4] = x[0]; scr[kk * 33 + n4 + 1] = x[1]; scr[kk * 33 + n4 + 2] = x[2]; scr[kk * 33 + n4 + 3] = x[3]; }
    asm volatile("s_waitcnt lgkmcnt(0)" ::: "memory");
    const int c = lane & 7;
#pragma unroll
    for (int j = 0; j < 4; ++j) { const int n = (lane >> 3) + 8 * j; const LAS float* sp = scr + (8 * c) * 33 + n;
        u32x4 o; o.x = cvt_pk_bf16(sp[0 * 33], sp[1 * 33]); o.y = cvt_pk_bf16(sp[2 * 33], sp[3 * 33]); o.z = cvt_pk_bf16(sp[4 * 33], sp[5 * 33]); o.w = cvt_pk_bf16(sp[6 * 33], sp[7 * 33]);
        *(u32x4*)(WT + (size_t)(row_off + n0 + n) * K + k0 + 8 * c) = o; }
    asm volatile("s_waitcnt lgkmcnt(0)" ::: "memory");
}
__device__ __forceinline__ void row_to_bf16(const float* xrow, bf16_t* orow, ss_t* ss, int lane) {
    const f32x4* xr = (const f32x4*)xrow + lane; f32x4 v[4]; float s = 0.f;
#pragma unroll
    for (int j = 0; j < 4; ++j) { v[j] = __builtin_nontemporal_load(xr + 64 * j); s += (v[j][0] * v[j][0] + v[j][1] * v[j][1]) + (v[j][2] * v[j][2] + v[j][3] * v[j][3]); }
    s = wave_sum(s);
#pragma unroll
    for (int j = 0; j < 4; ++j) st_bf16x4(orow + 4 * lane + 256 * j, v[j]);
    if (lane == 0) *ss = ss_fix(s);
}

constexpr int KV_STRIDE = 288;
constexpr int ATT_STAGE = 32768, ATT_NST = 4;
typedef float f32x16 __attribute__((ext_vector_type(16)));
#define MFMA32(a, b, c) __builtin_amdgcn_mfma_f32_32x32x16_bf16((a), (b), (c), 0, 0, 0)
struct AttnArgs {
    const bf16_t* q; bf16_t* o;
    const bf16_t* kb; const bf16_t* vb;
    int nq, nk, qpos0, lim_base; float slope_l2;
    const unsigned* kmaxp;
};
__device__ __forceinline__ constexpr int crow32(int i, int hi) { return (i & 3) + 8 * (i >> 2) + 4 * hi; }
template <int NC>
__device__ __forceinline__ void attn_unit(LAS unsigned char* lds, const AttnArgs& a, float lam, float post, const float* g_sub) {
    const int tid = opq_tid(), wid = __builtin_amdgcn_readfirstlane(tid >> 6), lane = tid & 63, r = lane & 31, hi = lane >> 5, l16 = lane & 15, g1 = (lane >> 4) & 1;
    constexpr int KS = (NC == 2) ? 4 : 8;
    const int rg = (NC == 2) ? (wid & 3) : wid, comp = (NC == 2) ? (wid >> 2) : 0;
    const int ntiles = (a.nk + 63) >> 6, q0w = rg * 32;
    const bool active = q0w < a.nq;
    const int tile_lim = a.lim_base + (rg >> 1);
    unsigned goffK[2], goffV[2];
#pragma unroll
    for (int j = 0; j < 2; ++j) { const int row = wid * 8 + j * 4 + (lane >> 4), cl = lane & 15;
        goffK[j] = (unsigned)(row * 512 + ((cl ^ (row & 15)) << 3)) * 2u; goffV[j] = (unsigned)(row * 512 + ((cl ^ ((row & 3) << 2)) << 3)) * 2u; }
#define ATT_DMA1(gp_, la_) asm volatile("s_mov_b32 m0, %1\n\ts_nop 0\n\tglobal_load_lds_dwordx4 %0, off" :: "v"(gp_), "s"(la_) : "memory", "m0")
#define ATT_DMA(kt_, st_) do { const char* kg_ = (const char*)(a.kb + (size_t)(kt_) * 64 * 512); const char* vg_ = (const char*)(a.vb + (size_t)(kt_) * 64 * 512); \
        const unsigned lb_ = (unsigned)(__UINTPTR_TYPE__)lds + (unsigned)((st_) * ATT_STAGE) + (unsigned)wid * 2048u; _Pragma("unroll") for (int j = 0; j < 2; ++j) { \
        ATT_DMA1(kg_ + goffK[j], lb_ + j * 1024); ATT_DMA1(vg_ + goffV[j], lb_ + 16384 + j * 1024); } } while (0)
    { const int t0 = ntiles - 1, t1 = t0 > 0 ? t0 - 1 : 0; ATT_DMA(t0, 0); ATT_DMA(t1, 1); }
    bf16x8 qf[KS];
#pragma unroll
    for (int ks = 0; ks < KS; ++ks) qf[ks] = (bf16x8){0, 0, 0, 0, 0, 0, 0, 0};
    if (active) {
        const bf16_t* qp = a.q + (size_t)(q0w + r) * DM + comp * 64 + hi * 8;
#pragma unroll
        for (int ks = 0; ks < KS; ++ks) qf[ks] = *(const bf16x8*)(qp + ks * 16);
    }
    asm volatile("s_waitcnt vmcnt(0)" ::: "memory");
#pragma unroll
    for (int ks = 0; ks < KS; ++ks) asm volatile("" : "+v"(qf[ks]));
    f32x16 O[4]; float mrun = -1e30f, lrun = 0.f;
#pragma unroll
    for (int dt = 0; dt < 4; ++dt)
#pragma unroll
        for (int i = 0; i < 16; ++i) O[dt][i] = 0.f;
    const int qpos = a.qpos0 + q0w + r;
    f32x16 BIAS[2];
#pragma unroll
    for (int st = 0; st < 2; ++st)
#pragma unroll
        for (int i = 0; i < 16; ++i) BIAS[st][i] = (NC == 2) ? a.slope_l2 * (float)(st * 32 + crow32(i, 0) + 4 * hi - qpos) : 0.f;
    unsigned koff[KS], voff[4];
#pragma unroll
    for (int ks = 0; ks < KS; ++ks) koff[ks] = (unsigned)(r * 256 + (((comp * 8 + ks * 2 + hi) ^ (r & 15)) << 4));
    { const int q4 = l16 >> 2, p4 = l16 & 3;
#pragma unroll
      for (int dt = 0; dt < 4; ++dt) voff[dt] = (unsigned)(16384 + (4 * hi + q4) * 256 + ((dt ^ q4) << 6) + (g1 << 5) + ((p4 >> 1) << 4) + ((p4 & 1) << 3)); }
    const bool term = (NC == 2) && (a.kmaxp != nullptr);
    float ubq = 3.0e38f;
    volatile LAS unsigned* tf = (volatile LAS unsigned*)(lds + 131072 + 64);
    if (term) {
        float ssq = 0.f;
#pragma unroll
        for (int ks = 0; ks < KS; ++ks)
#pragma unroll
            for (int e = 0; e < 8; ++e) { const float f = __uint_as_float(((unsigned)(unsigned short)qf[ks][e]) << 16); ssq += f * f; }
        ssq += __shfl_xor(ssq, 32);
        ubq = sqrtf(ssq) * __uint_as_float(a.kmaxp[comp]) * 1.01f + 0.5f;
        if (lane == 0) { tf[wid] = 0u; tf[8 + wid] = 0u; }
    }
#define ATT_PV1(N, OA, OB) do { s16x4 l0_, h0_, l1_, h1_, l2_, h2_, l3_, h3_; \
        asm volatile("ds_read_b64_tr_b16 %0, %8 offset:" #OA "\n\tds_read_b64_tr_b16 %1, %8 offset:" #OB "\n\t" \
                     "ds_read_b64_tr_b16 %2, %9 offset:" #OA "\n\tds_read_b64_tr_b16 %3, %9 offset:" #OB "\n\t" \
                     "ds_read_b64_tr_b16 %4, %10 offset:" #OA "\n\tds_read_b64_tr_b16 %5, %10 offset:" #OB "\n\t" \
                     "ds_read_b64_tr_b16 %6, %11 offset:" #OA "\n\tds_read_b64_tr_b16 %7, %11 offset:" #OB "\n\ts_waitcnt lgkmcnt(0)" \
                     : "=&v"(l0_), "=&v"(h0_), "=&v"(l1_), "=&v"(h1_), "=&v"(l2_), "=&v"(h2_), "=&v"(l3_), "=&v"(h3_) : "v"(va0_), "v"(va1_), "v"(va2_), "v"(va3_) : "memory"); \
        O[0] = MFMA32(__builtin_shufflevector(l0_, h0_, 0, 1, 2, 3, 4, 5, 6, 7), pfp[N], O[0]); O[1] = MFMA32(__builtin_shufflevector(l1_, h1_, 0, 1, 2, 3, 4, 5, 6, 7), pfp[N], O[1]); \
        O[2] = MFMA32(__builtin_shufflevector(l2_, h2_, 0, 1, 2, 3, 4, 5, 6, 7), pfp[N], O[2]); O[3] = MFMA32(__builtin_shufflevector(l3_, h3_, 0, 1, 2, 3, 4, 5, 6, 7), pfp[N], O[3]); } while (0)
#define ATT_PV(sva_) do { const unsigned va0_ = (sva_) + voff[0], va1_ = (sva_) + voff[1], va2_ = (sva_) + voff[2], va3_ = (sva_) + voff[3]; \
        ATT_PV1(0, 0, 2048); ATT_PV1(1, 4096, 6144); ATT_PV1(2, 8192, 10240); ATT_PV1(3, 12288, 14336); } while (0)
    const bool lag = wid >= 4;
    bf16x8 pfp[4]; bool pend = false; unsigned psva = 0u;
#pragma unroll
    for (int n = 0; n < 4; ++n) pfp[n] = (bf16x8){0, 0, 0, 0, 0, 0, 0, 0};
    const unsigned lds0 = (unsigned)(__UINTPTR_TYPE__)lds;
    int stg = 0;
    for (int kt = ntiles - 1; kt >= 0; --kt, stg = (stg + 1) & 3) {
        asm volatile("s_waitcnt vmcnt(4) lgkmcnt(0)" ::: "memory"); __builtin_amdgcn_s_barrier(); asm volatile("" ::: "memory");
        if (term) {
            const LAS u32x4* fp = (const LAS u32x4*)(lds + 131072 + 64 + (kt & 1) * 32); const u32x4 fa = fp[0], fb = fp[1];
            if (((fa.x & fa.y) & (fa.z & fa.w) & (fb.x & fb.y) & (fb.z & fb.w)) != 0u) break; }
        { const int tn = kt >= 2 ? kt - 2 : 0; ATT_DMA(tn, (stg + 2) & 3); }
        if (lag && pend) { ATT_PV(psva); pend = false; }
        bool dob = false;
        const unsigned sba = lds0 + (unsigned)(stg * ATT_STAGE);
        if (active && kt <= tile_lim) {
            const bool gen = ((NC == 2) && (kt * 64 + 63 >= a.qpos0)) || (kt * 64 + 64 > a.nk);
            f32x16 S[2]; S[0] = BIAS[0]; S[1] = BIAS[1];
#define ATT_K22(K0) do { bf16x8 f0_, f1_, f2_, f3_; \
                asm volatile("ds_read_b128 %0, %4 offset:0\n\tds_read_b128 %1, %4 offset:8192\n\tds_read_b128 %2, %5 offset:0\n\tds_read_b128 %3, %5 offset:8192\n\ts_waitcnt lgkmcnt(0)" \
                             : "=&v"(f0_), "=&v"(f1_), "=&v"(f2_), "=&v"(f3_) : "v"(sba + koff[K0]), "v"(sba + koff[K0 + 1]) : "memory"); \
                S[0] = MFMA32(f0_, qf[K0], S[0]); S[1] = MFMA32(f1_, qf[K0], S[1]); S[0] = MFMA32(f2_, qf[K0 + 1], S[0]); S[1] = MFMA32(f3_, qf[K0 + 1], S[1]); } while (0)
            ATT_K22(0); ATT_K22(2); if (KS == 8) { ATT_K22(KS - 4); ATT_K22(KS - 2); }
#undef ATT_K22
            float toff = 0.f, mx = -1e30f;
            if (gen) {
#pragma unroll
                for (int st = 0; st < 2; ++st)
#pragma unroll
                    for (int i = 0; i < 16; ++i) { const int kpos = kt * 64 + st * 32 + crow32(i, 0) + 4 * hi;
                        float sv = S[st][i] - BIAS[st][i]; if (NC == 2) sv -= a.slope_l2 * fabsf((float)(qpos - kpos)); if (kpos >= a.nk) sv = -1e30f; S[st][i] = sv; mx = fmaxf(mx, sv); }
            } else {
                if (NC == 2) toff = a.slope_l2 * (float)(kt * 64);
#pragma unroll
                for (int st = 0; st < 2; ++st)
#pragma unroll
                    for (int i = 0; i < 16; ++i) mx = fmaxf(mx, S[st][i]);
            }
            mx = fmaxf(mx, __shfl_xor(mx, 32)) + toff;
            const bool dead = (NC == 2) && (mx < mrun - 160.f);
            if (!__all(dead)) {
                const float mn = fmaxf(mrun, mx), alpha = __builtin_amdgcn_exp2f(mrun - mn), d = toff - mn; mrun = mn;
                float ps = 0.f;
#pragma unroll
                for (int st = 0; st < 2; ++st)
#pragma unroll
                    for (int i = 0; i < 16; ++i) { const float pv = __builtin_amdgcn_exp2f(S[st][i] + d); S[st][i] = pv; ps += pv; }
                lrun = lrun * alpha + ps;
                if (!__all(alpha == 1.f)) {
#pragma unroll
                    for (int dt = 0; dt < 4; ++dt) O[dt] = O[dt] * alpha;
                }
#pragma unroll
                for (int n = 0; n < 4; ++n) { const int st = n >> 1, sp = n & 1;
                    u32x4 w; w.x = cvt_pk_bf16(S[st][8 * sp + 0], S[st][8 * sp + 1]); w.y = cvt_pk_bf16(S[st][8 * sp + 2], S[st][8 * sp + 3]);
                    w.z = cvt_pk_bf16(S[st][8 * sp + 4], S[st][8 * sp + 5]); w.w = cvt_pk_bf16(S[st][8 * sp + 6], S[st][8 * sp + 7]); pfp[n] = __builtin_bit_cast(bf16x8, w); }
                dob = true;
            }
        }
        if (dob) { if (lag) { pend = true; psva = sba; } else ATT_PV(sba); }
        if (term) { const float ub = ubq - a.slope_l2 * fmaxf(0.f, (float)(qpos - ((kt - 1) * 64 + 63))); const bool done = ub < mrun - 150.f; const unsigned fl = __all(done) ? 1u : 0u; if (lane == 0) tf[((kt - 1) & 1) * 8 + wid] = fl; }
    }
    if (lag && pend) ATT_PV(psva);
#undef ATT_PV
#undef ATT_PV1
#undef ATT_DMA
#undef ATT_DMA1
    asm volatile("s_waitcnt vmcnt(0)" ::: "memory");
    __syncthreads();
    float linv = 0.f;
    { float l = lrun; l += __shfl_xor(l, 32); linv = 1.f / l; }
    bf16_t* op = a.o + (size_t)(q0w + r) * DM + 4 * hi;
    if (NC == 1) {
        if (active) {
#pragma unroll
            for (int dt = 0; dt < 4; ++dt)
#pragma unroll
                for (int g = 0; g < 4; ++g) st_bf16x4(op + dt * 32 + 8 * g, (f32x4){O[dt][4 * g], O[dt][4 * g + 1], O[dt][4 * g + 2], O[dt][4 * g + 3]} * linv);
        }
    } else {
        LAS f32x4* xch = (LAS f32x4*)lds;
        if (active && comp == 1) {
#pragma unroll
            for (int dt = 0; dt < 4; ++dt)
#pragma unroll
                for (int g = 0; g < 4; ++g) xch[(rg * 16 + dt * 4 + g) * 64 + lane] = (f32x4){O[dt][4 * g], O[dt][4 * g + 1], O[dt][4 * g + 2], O[dt][4 * g + 3]} * linv;
        }
        __syncthreads();
        if (active && comp == 0) {
            float ssq = 0.f;
#pragma unroll
            for (int dt = 0; dt < 4; ++dt)
#pragma unroll
                for (int g = 0; g < 4; ++g) { const f32x4 o1 = xch[(rg * 16 + dt * 4 + g) * 64 + lane];
#pragma unroll
                    for (int e = 0; e < 4; ++e) { const float o = O[dt][4 * g + e] * linv - lam * o1[e]; O[dt][4 * g + e] = o; ssq += o * o; } }
            ssq += __shfl_xor(ssq, 32);
            const float rr = rsqrtf(ssq * (1.f / 128.f) + EPS) * post;
            f32x4 gg[4][4];
#pragma unroll
            for (int dt = 0; dt < 4; ++dt)
#pragma unroll
                for (int g = 0; g < 4; ++g) gg[dt][g] = *(const f32x4*)(g_sub + dt * 32 + 8 * g + 4 * hi);
            __builtin_amdgcn_sched_barrier(0);
#pragma unroll
            for (int dt = 0; dt < 4; ++dt)
#pragma unroll
                for (int g = 0; g < 4; ++g) st_bf16x4(op + dt * 32 + 8 * g, (f32x4){O[dt][4 * g], O[dt][4 * g + 1], O[dt][4 * g + 2], O[dt][4 * g + 3]} * gg[dt][g] * rr);
        }
        __syncthreads();
    }
}

__device__ __forceinline__ void pool_unit(LAS unsigned char* lds, const bf16_t* z, int r0, int nrows, int t0, const float* hist, bool prompt, const bf16_t* WpT, bf16_t* mix, int g) {
    const int tid = opq_tid(), wid = __builtin_amdgcn_readfirstlane(tid >> 6), lane = tid & 63, fr = lane & 15, fq = lane >> 4;
    {
        bf16x8 val[5];
#pragma unroll
        for (int c = 0; c < 5; ++c) { const int idx = tid + 512 * c, j = idx >> 4, c8 = idx & 15; val[c] = (bf16x8){0, 0, 0, 0, 0, 0, 0, 0};
            if (idx < (nrows + 15) * 16) {
                if (j >= 15 || (hist == nullptr && t0 > 0)) val[c] = *(const bf16x8*)(z + (size_t)(r0 - 15 + j) * DM + g * 128 + c8 * 8);
                else if (hist != nullptr) { const f32x4 h0 = *(const f32x4*)(hist + (size_t)j * 512 + g * 128 + c8 * 8), h1 = *(const f32x4*)(hist + (size_t)j * 512 + g * 128 + c8 * 8 + 4);
                    u32x4 w; w.x = cvt_pk_bf16(h0[0], h0[1]); w.y = cvt_pk_bf16(h0[2], h0[3]); w.z = cvt_pk_bf16(h1[0], h1[1]); w.w = cvt_pk_bf16(h1[2], h1[3]); val[c] = __builtin_bit_cast(bf16x8, w); } } }
        bf16x8 wfr[8][4];
        { const bf16_t* wp = WpT + (size_t)g * 16384 + (size_t)fr * 128 + fq * 8;
#pragma unroll
          for (int nt = 0; nt < 8; ++nt)
#pragma unroll
              for (int ks = 0; ks < 4; ++ks) wfr[nt][ks] = *(const bf16x8*)(wp + nt * 16 * 128 + ks * 32); }
#pragma unroll
        for (int c = 0; c < 5; ++c) { const int idx = tid + 512 * c, j = idx >> 4, c8 = idx & 15; if (idx < (nrows + 15) * 16) *(LAS bf16x8*)(lds + j * KV_STRIDE + c8 * 16) = val[c]; }
        __syncthreads();
        if (wid * 16 < nrows) {
            const int win = 2 << g, jr = 15 + wid * 16 + fr, t = t0 + wid * 16 + fr;
            const float icnt = 1.f / (float)(prompt ? (t + 1 < win ? t + 1 : win) : win);
            bf16x8 af[4];
#pragma unroll
            for (int ks = 0; ks < 4; ++ks) {
                float sum[8], u[8];
#pragma unroll
                for (int e = 0; e < 8; ++e) sum[e] = 0.f;
                for (int i = 0; i < win; ++i) { const bf16x8 v = *(const LAS bf16x8*)(lds + (jr - i) * KV_STRIDE + ks * 64 + fq * 16);
#pragma unroll
                    for (int e = 0; e < 8; ++e) { const float f = __uint_as_float(((unsigned)(unsigned short)v[e]) << 16); sum[e] += f; if (i == 0) u[e] = f; } }
                u32x4 w; w.x = cvt_pk_bf16(sum[0] * icnt - u[0], sum[1] * icnt - u[1]); w.y = cvt_pk_bf16(sum[2] * icnt - u[2], sum[3] * icnt - u[3]);
                w.z = cvt_pk_bf16(sum[4] * icnt - u[4], sum[5] * icnt - u[5]); w.w = cvt_pk_bf16(sum[6] * icnt - u[6], sum[7] * icnt - u[7]); af[ks] = __builtin_bit_cast(bf16x8, w);
            }
            bf16_t* op = mix + (size_t)(r0 + wid * 16 + fr) * DM + g * 128 + 4 * fq;
#pragma unroll
            for (int nt = 0; nt < 8; ++nt) { f32x4 acc = {0.f, 0.f, 0.f, 0.f};
#pragma unroll
                for (int ks = 0; ks < 4; ++ks) acc = MFMA16(wfr[nt][ks], af[ks], acc);
                st_bf16x4(op + nt * 16, acc); }
        }
        __syncthreads();
    }
}

#define XB_TMO      128
#define XB_XCNT(j)  (256  + 64 * (j))
#define XB_XSUB(j)  (1280 + 64 * (j))
#define XB_XGEN(j)  (2304 + 64 * (j))
#define XB_TOP      3328
#define XB_TOPGEN   3392
#define XCD_BAR_WORDS 3456
#define XB_SPIN_CAP (1u << 18)

__device__ __forceinline__ unsigned xb_ld(unsigned* p)              { return __hip_atomic_load(p, __ATOMIC_RELAXED, __HIP_MEMORY_SCOPE_AGENT); }
__device__ __forceinline__ unsigned xb_add(unsigned* p, unsigned v) { return __hip_atomic_fetch_add(p, v, __ATOMIC_RELAXED, __HIP_MEMORY_SCOPE_AGENT); }
__device__ __forceinline__ unsigned xb_xcc_id() { return (unsigned)__builtin_amdgcn_s_getreg((3 << 11) | 20) & 0xFu; }
#define XB_SPIN(cond, bar) do { unsigned _sp = 0; while (cond) { __builtin_amdgcn_s_sleep(1); \
    if ((++_sp & 255u) == 0u) { if (xb_ld(&(bar)[XB_TMO])) break; if (_sp > XB_SPIN_CAP) { atomicAdd(&(bar)[XB_TMO], 1u); break; } } } } while (0)

struct XcdBarrier {
    unsigned* bar; unsigned x;
    volatile LAS unsigned* st;
};

__device__ __forceinline__ XcdBarrier xcd_barrier_post(unsigned* bar, volatile LAS unsigned* st) {
    XcdBarrier b; b.bar = bar; b.x = xb_xcc_id(); b.st = st;
    if (threadIdx.x == 0) (void)xb_add(&bar[XB_XCNT(b.x)], 1u);
    return b;
}
__device__ __forceinline__ void xcd_barrier_complete(unsigned* bar, unsigned x, unsigned& nloc, unsigned& nx) {
    const unsigned G = gridDim.x * gridDim.y * gridDim.z;
    unsigned sum, cnt, mine, sp = 0u;
    for (;;) {
        sum = 0u; cnt = 0u; mine = 0u;
#pragma unroll
        for (unsigned j = 0; j < 16; ++j) { const unsigned c = xb_ld(&bar[XB_XCNT(j)]); sum += c; cnt += (c > 0u) ? 1u : 0u; mine = (j == x) ? c : mine; }
        if (sum == G) break;
        __builtin_amdgcn_s_sleep(1);
        if ((++sp & 255u) == 0u) { if (xb_ld(&bar[XB_TMO])) break; if (sp > XB_SPIN_CAP) { atomicAdd(&bar[XB_TMO], 1u); break; } }
    }
    nloc = mine > 0u ? mine : 1u; nx = cnt > 0u ? cnt : 1u;
}

__device__ __forceinline__ void xcd_barrier(const XcdBarrier& b) {
    asm volatile("s_waitcnt vmcnt(0)" ::: "memory");
    __syncthreads();
    if (threadIdx.x == 0) {
        unsigned* bar = b.bar;
        __builtin_amdgcn_s_waitcnt(0);
        unsigned nloc = b.st[0], nx = b.st[1];
        if (nloc == 0u) { xcd_barrier_complete(bar, b.x, nloc, nx); b.st[0] = nloc; b.st[1] = nx; }
        const unsigned old = xb_add(&bar[XB_XSUB(b.x)], 1u);
        const unsigned gen = old / nloc;
        if (old + 1u == (gen + 1u) * nloc) {
            __builtin_amdgcn_fence(__ATOMIC_RELEASE, "agent");
            asm volatile("s_waitcnt vmcnt(0)" ::: "memory");
            const unsigned og = xb_add(&bar[XB_TOP], 1u);
            const unsigned tg = og / nx;
            if (og + 1u == (tg + 1u) * nx) xb_add(&bar[XB_TOPGEN], 1u);
            else XB_SPIN(xb_ld(&bar[XB_TOPGEN]) == tg, bar);
            __builtin_amdgcn_fence(__ATOMIC_ACQUIRE, "agent");
            xb_add(&bar[XB_XGEN(b.x)], 1u);
            asm volatile("s_waitcnt vmcnt(0)" ::: "memory");
        } else {
            XB_SPIN(xb_ld(&bar[XB_XGEN(b.x)]) == gen, bar);
            __builtin_amdgcn_fence(__ATOMIC_ACQUIRE, "agent");
            asm volatile("s_waitcnt vmcnt(0)" ::: "memory");
        }
    }
    __syncthreads();
}

__global__ void __launch_bounds__(512, 2) yoco_fwd(Params p) {
    extern __shared__ __attribute__((aligned(16))) unsigned char lds_raw[];
    LAS unsigned char* lds = (LAS unsigned char*)lds_raw;
    const int G = gridDim.x, NGW = G * 8;
#define PH_IDS const int tid = opq_tid(), wid = __builtin_amdgcn_readfirstlane(tid >> 6), lane = tid & 63, gw = blockIdx.x * 8 + wid; (void)gw; (void)lane
    unsigned char* ws = p.ws; float* out = p.out;
    ss_t* ss0 = (ss_t*)(ws + WS_SS); ss_t* ss1 = ss0 + NR; ss_t* ss2 = ss1 + NR; ss_t* ss3 = ss2 + NR; ss_t* ss4 = ss3 + NR; ss_t* ssm = ss4 + NR;
    unsigned* pcnt = (unsigned*)(ws + WS_Q) + 1024;
    const bool fuse_final = (G == 256);
    bf16_t* xb = (bf16_t*)(ws + WS_XB); bf16_t* memb = (bf16_t*)(ws + WS_MEMB); bf16_t* zb = (bf16_t*)(ws + WS_Z); bf16_t* mix = (bf16_t*)(ws + WS_MIX); bf16_t* hid = (bf16_t*)(ws + WS_HID); bf16_t* ybf = (bf16_t*)(out + O_Y); bf16_t* kbuf = (bf16_t*)(ws + WS_KB); bf16_t* vbuf = (bf16_t*)(ws + WS_VB);
    const float* x_prompt = p.in[0]; const float* x_sample = p.in[1];
    const int lo = p.ph_lo, hi = p.ph_hi;
    volatile LAS unsigned* misc = (volatile LAS unsigned*)(lds + 131072);
    { const int t0 = opq_tid(); if (t0 < 16) misc[t0] = 0u; }
    __syncthreads();
    unsigned* barw = (unsigned*)(ws + WS_BAR);
    XcdBarrier bar = xcd_barrier_post(barw, misc);
    if (p.ph_lo < 0) cg::this_grid().sync();
#define IN(k) (lo <= (k) && (k) < hi)
#define SEAM(k) do { if (IN(k) && IN((k) + 1)) xcd_barrier(bar); } while (0)

    if (IN(0)) for (int rep0 = 0; rep0 < REP0; ++rep0) {
        PH_IDS;
        LAS float* scr = (LAS float*)(lds + wid * 8448);
        constexpr int I_SQ = 16 * 32, I_F1 = 16 * 128, I_F2 = 64 * 32, I_P = 2 * 4;
        constexpr int NITEMS = 7 * I_SQ + 2 * I_F1 + 2 * I_F2 + 4 * I_P;
        for (int it = gw; it < NITEMS; it += NGW) {
            int r = it;
            if (r < 7 * I_SQ) { const int m = r / I_SQ; r -= m * I_SQ;
                if (m == 0) transpose_item(p.in[9], DM, DM, p.in[8], nullptr, (bf16_t*)(ws + WS_WIN0), 0, scr, r, lane);
                else if (m == 1) transpose_item(p.in[9] + (size_t)DM * DM, DM, DM, p.in[8] + DM, nullptr, (bf16_t*)(ws + WS_WINKV1), 0, scr, r, lane);
                else if (m == 2) transpose_item(p.in[21], DM, DM, p.in[20], nullptr, (bf16_t*)(ws + WS_WINKV1), DM, scr, r, lane);
                else if (m == 3) transpose_item(p.in[10], DM, DM, nullptr, nullptr, (bf16_t*)(ws + WS_WOUT0), 0, scr, r, lane);
                else if (m == 4) transpose_item(p.in[10] + (size_t)DM * DM, DM, DM, nullptr, nullptr, (bf16_t*)(ws + WS_WOUT1), 0, scr, r, lane);
                else if (m == 5) transpose_item(p.in[12], DM, DM, p.in[11], nullptr, (bf16_t*)(ws + WS_WMEM0), 0, scr, r, lane);
                else transpose_item(p.in[12] + (size_t)DM * DM, DM, DM, p.in[11] + DM, nullptr, (bf16_t*)(ws + WS_WMEM1), 0, scr, r, lane);
                continue; }
            r -= 7 * I_SQ;
            if (r < 2 * I_F1) { const int l = r / I_F1; r -= l * I_F1; transpose_item(p.in[14] + (size_t)l * DM * FF, DM, FF, p.in[13] + l * DM, nullptr, (bf16_t*)(ws + (l ? WS_WFF1_1 : WS_WFF1_0)), 0, scr, r, lane); continue; }
            r -= 2 * I_F1;
            if (r < 2 * I_F2) { const int l = r / I_F2; r -= l * I_F2; transpose_item(p.in[15] + (size_t)l * FF * DM, FF, DM, nullptr, nullptr, (bf16_t*)(ws + (l ? WS_WFF2_1 : WS_WFF2_0)), 0, scr, r, lane); continue; }
            r -= 2 * I_F2;
            { const int g = r / I_P; r -= g * I_P; transpose_item(p.in[16] + (size_t)g * 16384, 128, 128, nullptr, p.in[17] + g * 128, (bf16_t*)(ws + WS_WPOOL) + (size_t)g * 16384, 0, scr, r, lane); }
        }
        for (int m = gw * 2; m < NR; m += NGW * 2) {
            const float* r0p = m < NP ? x_prompt + (size_t)m * DM : x_sample + (size_t)(m - NP) * DM; const float* r1p = (m + 1) < NP ? x_prompt + (size_t)(m + 1) * DM : x_sample + (size_t)(m + 1 - NP) * DM;
            f32x4 va[4], vb4[4]; float sa = 0.f, sb2 = 0.f;
#pragma unroll
            for (int j = 0; j < 4; ++j) { va[j] = __builtin_nontemporal_load(((const f32x4*)r0p) + lane + 64 * j); vb4[j] = __builtin_nontemporal_load(((const f32x4*)r1p) + lane + 64 * j); }
#pragma unroll
            for (int j = 0; j < 4; ++j) { sa += (va[j][0] * va[j][0] + va[j][1] * va[j][1]) + (va[j][2] * va[j][2] + va[j][3] * va[j][3]); sb2 += (vb4[j][0] * vb4[j][0] + vb4[j][1] * vb4[j][1]) + (vb4[j][2] * vb4[j][2] + vb4[j][3] * vb4[j][3]);
                st_bf16x4(xb + (size_t)m * DM + 4 * lane + 256 * j, va[j]); st_bf16x4(xb + (size_t)(m + 1) * DM + 4 * lane + 256 * j, vb4[j]); }
            sa = wave_sum(sa); sb2 = wave_sum(sb2);
            if (lane == 0) { ss0[m] = ss_fix(sa); ss0[m + 1] = ss_fix(sb2); }
        }
        for (int m = gw; m < 512; m += NGW) row_to_bf16(p.in[2] + (size_t)m * DM, memb + (size_t)m * DM, ssm + m, lane);
        for (int i = blockIdx.x * 512 + tid; i < 4 * NR; i += G * 512) ss1[i] = 0ull;
        for (int m0 = gw * 4; m0 < 2 * 16384 + 2 * 4096 + 256; m0 += NGW * 4) {
            f32x4 v0[4], v1[4]; bf16_t* dstp[4];
#pragma unroll
            for (int j = 0; j < 4; ++j) { const int m = m0 + j; const float* src; bf16_t* dst;
                if (m < 32768) { const int kv = m >> 14, rr = m & 16383, b = rr >> 11, t = rr & 2047; src = p.in[3 + kv] + (size_t)rr * 512; dst = ybf + (kv ? Y_SVB : Y_SKB) + ((size_t)b * SKB_ROWS + t) * 512; }
                else if (m < 32768 + 8192) { const int mm = m - 32768, kv = mm >> 12, rr = mm & 4095, l = rr >> 11, rb = rr & 2047; src = p.in[5 + kv] + (size_t)rr * 512; dst = ybf + (kv ? Y_MVB : Y_MKB) + ((size_t)l * 10 * 256 + 512 + rb) * 512; }
                else { const int mm = m - 40960, b = mm >> 5, t = mm & 31; src = nullptr; dst = ybf + Y_SVB + ((size_t)b * SKB_ROWS + 2080 + t) * 512; }
                dstp[j] = dst; v0[j] = (f32x4){0.f, 0.f, 0.f, 0.f}; v1[j] = v0[j];
                if (src) { v0[j] = __builtin_nontemporal_load((const f32x4*)(src + 8 * lane)); v1[j] = __builtin_nontemporal_load((const f32x4*)(src + 8 * lane + 4)); } }
#pragma unroll
            for (int j = 0; j < 4; ++j) { u32x4 w; w.x = cvt_pk_bf16(v0[j][0], v0[j][1]); w.y = cvt_pk_bf16(v0[j][2], v0[j][3]); w.z = cvt_pk_bf16(v1[j][0], v1[j][1]); w.w = cvt_pk_bf16(v1[j][2], v1[j][3]);
                *(u32x4*)(dstp[j] + 8 * lane) = w; }
        }
    }
    SEAM(0);
    if (IN(1)) for (int rep1 = 0; rep1 < REP1; ++rep1) {
        FZ0 f{ss0, zb, out + O_POOLP, out + O_POOLS, nullptr};
        big_gemm8(lds, xb, (const bf16_t*)(ws + WS_WIN0), DM, DM, f);
        for (int rs_ = 0; rs_ < REPS; ++rs_) small_gemm<2, 2>(lds, xb + (size_t)NP * DM, (const bf16_t*)(ws + WS_WIN0), DM, NS / 32, DM / 32, NP, f);
        { FMemKV fm{ssm, out + O_MEMK, out + O_MEMV, ybf + Y_MKB, ybf + Y_MVB};
          for (int rs_ = 0; rs_ < REPS; ++rs_) small_gemm<4, 4>(lds, memb, (const bf16_t*)(ws + WS_WMEM0), DM, 512 / 64, 2 * DM / 64, 0, fm); }
    }
    SEAM(1);
    for (int layer = 0; layer < 2; ++layer) {
        const int ph = layer ? 7 : 2;
        if (IN(ph)) for (int rep = 0; rep < (layer ? REP7 : REP2); ++rep) {
            if (layer == 1) {
                const float* lq = p.in[18]; const int lane = opq_tid() & 63;
                const float d1 = wave_sum(lq[lane] * lq[64 + lane]), d2 = wave_sum(lq[128 + lane] * lq[192 + lane]);
                const float lam_i = 0.8f - 0.6f * expf(-0.3f), lam = expf(d1) - expf(d2) + lam_i;
                unsigned* kmx = (unsigned*)(ws + WS_BAR + 49152);
                unsigned* qc = (unsigned*)(ws + WS_Q);
#define Q_NEXT(q_, dst_) do { __syncthreads(); if (opq_tid() == 0) misc[2] = atomicAdd(qc + (q_), 1u); __syncthreads(); dst_ = (int)misc[2]; } while (0)
                const int xs = (int)(blockIdx.x & 7);
                if ((xs & 3) == 0) for (;;) {
                    int e; Q_NEXT(8, e); if (e >= 32) break;
                    const int b = e >> 2, h = e & 3; const size_t r0 = (size_t)NP + b * 32;
                    AttnArgs a; a.kmaxp = nullptr; a.q = zb + r0 * DM + h * 128; a.o = mix + r0 * DM + h * 128;
                    a.kb = ybf + Y_SKB + (size_t)b * SKB_ROWS * 512 + h * 128; a.vb = ybf + Y_SVB + (size_t)b * SKB_ROWS * 512 + h * 128;
                    a.nq = 32; a.nk = 2080; a.qpos0 = 2048; a.lim_base = 1 << 20; a.slope_l2 = exp2f(-2.f * (float)(h + 1)) * 1.4426950408889634f;
                    attn_unit<2>(lds, a, lam, 1.f - lam_i, p.in[19]);
                }
                for (int bh = xs;;) {
                    int u; Q_NEXT(bh, u);
                    if (u >= 64) {
                        __syncthreads();
                        { const int t_ = opq_tid(); if (t_ < 8) misc[4 + t_] = __hip_atomic_load(qc + t_, __ATOMIC_RELAXED, __HIP_MEMORY_SCOPE_AGENT); }
                        __syncthreads();
                        int pick = -1;
                        for (int s8 = 1; s8 < 8; ++s8) { const int c = (bh + s8) & 7; if (pick < 0 && misc[4 + c] < 64u) pick = c; }
                        if (pick < 0) break;
                        bh = pick; continue;
                    }
                    const int b = bh >> 2, h = bh & 3, qb = 63 - u; const size_t r0 = (size_t)b * 8192 + (size_t)qb * 128;
                    AttnArgs a; a.kmaxp = h < 2 ? kmx + (b * 4 + h) * 2 : nullptr;     a.q = zb + r0 * DM + h * 128; a.o = mix + r0 * DM + h * 128;
                    a.kb = kbuf + (size_t)b * 8192 * 512 + h * 128; a.vb = vbuf + (size_t)b * 8192 * 512 + h * 128;
                    a.nq = 128; a.nk = (2 * qb + 2) * 64; a.qpos0 = qb * 128; a.lim_base = 2 * qb; a.slope_l2 = exp2f(-2.f * (float)(h + 1)) * 1.4426950408889634f;
                    attn_unit<2>(lds, a, lam, 1.f - lam_i, p.in[19]);
                }
            } else {
                for (int uu = blockIdx.x; uu < 136 * 4; uu += G) {
                    const int g = 3 - uu / 136, u = uu % 136;
                    if (u < 128) pool_unit(lds, zb, u * 128, 128, (u & 63) * 128, nullptr, true, (const bf16_t*)(ws + WS_WPOOL), mix, g);
                    else { const int b = u - 128; pool_unit(lds, zb, NP + b * 32, 32, 0, p.in[7] + (size_t)b * 15 * 512, false, (const bf16_t*)(ws + WS_WPOOL), mix, g); }
                }
            }
            for (;;) {
                int e; { unsigned* qcm = (unsigned*)(ws + WS_Q) + 9 + layer; __syncthreads(); if (opq_tid() == 0) misc[2] = atomicAdd(qcm, 1u); __syncthreads(); e = (int)misc[2]; } if (e >= 288) break;
                AttnArgs a; a.kmaxp = nullptr; a.qpos0 = 0; a.lim_base = 1 << 20; a.slope_l2 = 0.f; a.nk = 256;
                const bf16_t* mkb = ybf + Y_MKB + (size_t)layer * 10 * 256 * 512; const bf16_t* mvb = ybf + Y_MVB + (size_t)layer * 10 * 256 * 512;
                if (e < 256) { const int tile = e >> 2, h = e & 3, b = tile >> 5; const size_t r0 = (size_t)tile * 256;
                    a.q = zb + r0 * DM + 512 + h * 128; a.o = mix + r0 * DM + 512 + h * 128; a.nq = 256;
                    a.kb = mkb + (size_t)b * 256 * 512 + h * 128; a.vb = mvb + (size_t)b * 256 * 512 + h * 128; }
                else { const int b = (e - 256) >> 2, h = e & 3; const size_t r0 = (size_t)NP + b * 32;
                    a.q = zb + r0 * DM + 512 + h * 128; a.o = mix + r0 * DM + 512 + h * 128; a.nq = 32;
                    a.kb = mkb + (size_t)(2 + b) * 256 * 512 + h * 128; a.vb = mvb + (size_t)(2 + b) * 256 * 512 + h * 128; }
                attn_unit<1>(lds, a, 0.f, 1.f, nullptr);
            }
        }
        SEAM(ph);
        if (IN(ph + 1)) {
            FRes f{nullptr, xb, xb, layer ? ss3 : ss1, nullptr};
            const bf16_t* W = (const bf16_t*)(ws + (layer ? WS_WOUT1 : WS_WOUT0));
            big_gemm8(lds, mix, W, DM, DM, f);
            small_gemm<2, 2>(lds, mix + (size_t)NP * DM, W, DM, NS / 32, DM / 32, NP, f);
        }
        SEAM(ph + 1);
        if (IN(ph + 2)) for (int rep4 = 0; rep4 < REP4; ++rep4) {
            FFfn1 f{layer ? ss3 : ss1, hid, nullptr};
            const bf16_t* W = (const bf16_t*)(ws + (layer ? WS_WFF1_1 : WS_WFF1_0));
            big_gemm8(lds, xb, W, FF, DM, f);
            for (int rs_ = 0; rs_ < REPS; ++rs_) small_gemm<4, 4>(lds, xb + (size_t)NP * DM, W, DM, NS / 64, FF / 64, NP, f);
        }
        SEAM(ph + 2);
        if (IN(ph + 3)) {
            FRes f{layer ? out + O_Y : nullptr, xb, layer ? nullptr : xb, layer ? nullptr : ss2, nullptr};
            const bf16_t* W = (const bf16_t*)(ws + (layer ? WS_WFF2_1 : WS_WFF2_0));
            if (layer == 1 && fuse_final) {
                pg8::Gemm g{hid, W, NP, DM, FF}; pg8::StaticOrder S; S.init(NP, DM, G, (int)blockIdx.x);
                pg8::EpiFinal E{xb, out + O_Y, p.in[22], ss4, pcnt};
                pg8::gemm_phase<pg8::EpiFinal, pg8::StaticOrder, false, true>(lds, g, S, E);
            } else
            big_gemm8(lds, hid, W, DM, FF, f);
            small_gemm<2, 2>(lds, hid + (size_t)NP * FF, W, FF, NS / 32, DM / 32, NP, f);
        }
        SEAM(ph + 3);
        if (layer == 0) {
            if (IN(6)) for (int rep6 = 0; rep6 < REP6; ++rep6) {
                FZkv f{ss2, zb, out, kbuf, vbuf, ybf + Y_SKB, ybf + Y_SVB, nullptr};
                big_gemm8(lds, xb, (const bf16_t*)(ws + WS_WINKV1), 2 * DM, DM, f);
                for (int rs_ = 0; rs_ < REPS; ++rs_) small_gemm<4, 2>(lds, xb + (size_t)NP * DM, (const bf16_t*)(ws + WS_WINKV1), DM, NS / 64, 2 * DM / 32, NP, f);
                {
                    asm volatile("s_waitcnt vmcnt(0)" ::: "memory"); __syncthreads();
                    unsigned* kmx = (unsigned*)(ws + WS_BAR + 49152); LAS float* kred = (LAS float*)lds;
                    const int tid_ = opq_tid(), wid_ = __builtin_amdgcn_readfirstlane(tid_ >> 6), ln_ = tid_ & 63, l32 = ln_ & 31;
                    int upm = 0, upn = 0;
                    for (int i = 0; static_unit(NP, 2 * DM, G, (int)blockIdx.x, i, upm, upn); ++i) if (upn == 4 || upn == 5) {
                        float smax = 0.f;
#pragma unroll 1
                        for (int j = 0; j < 16; ++j) { const bf16x8 v = *(const bf16x8*)(kbuf + (size_t)(upm * 256 + wid_ * 32 + 2 * j + (ln_ >> 5)) * 512 + (upn - 4) * 256 + l32 * 8); float sq = 0.f;
#pragma unroll
                            for (int e = 0; e < 8; ++e) { const float fv = __uint_as_float(((unsigned)(unsigned short)v[e]) << 16); sq += fv * fv; }
                            sq += __shfl_xor(sq, 1); sq += __shfl_xor(sq, 2); sq += __shfl_xor(sq, 4); smax = fmaxf(smax, sq); }
                        smax = fmaxf(smax, __shfl_xor(smax, 32));
                        if ((ln_ & 39) == 0) kred[wid_ * 4 + (l32 >> 3)] = smax;
                        __syncthreads();
                        if (tid_ < 4) { float m8 = kred[tid_];
#pragma unroll
                            for (int w = 1; w < 8; ++w) m8 = fmaxf(m8, kred[w * 4 + tid_]);
                            atomicMax(kmx + ((upm >> 5) * 4 + (upn - 4) * 2 + (tid_ >> 1)) * 2 + (tid_ & 1), __float_as_uint(sqrtf(m8))); }
                        __syncthreads();
                    }
                }
            }
            SEAM(6);
        }
    }
    if (IN(11)) {
        PH_IDS;
        const float* gf = p.in[22];
        for (int m = (fuse_final ? NP : 0) + gw; m < NR; m += NGW) {
            f32x4* xr = (f32x4*)(out + O_Y + (size_t)m * DM) + lane; f32x4 v[4]; float s = 0.f;
#pragma unroll
            for (int j = 0; j < 4; ++j) { v[j] = __builtin_nontemporal_load(xr + 64 * j); s += (v[j][0] * v[j][0] + v[j][1] * v[j][1]) + (v[j][2] * v[j][2] + v[j][3] * v[j][3]); }
            const float r = rsqrtf(wave_sum(s) * (1.f / 1024.f) + EPS);
#pragma unroll
            for (int j = 0; j < 4; ++j) xr[64 * j] = v[j] * r * ((const f32x4*)gf)[lane + 64 * j];
        }
    }
#undef IN
#undef SEAM
}

extern "C" void kernel_launch(void* const* d_in, const int* in_sizes, int n_in, void* d_out, int out_size, void* d_ws, size_t ws_size, hipStream_t stream) {
    static int grid = 0;
    if (grid == 0) {
        int dev = 0, cus = 0, per_cu = 0;
        if (n_in != 23 || ws_size < WS_END) { fprintf(stderr, "kernel_launch: unexpected n_in %d / ws %zu\n", n_in, ws_size); grid = -1; return; }
        hipGetDevice(&dev); hipDeviceGetAttribute(&cus, hipDeviceAttributeMultiprocessorCount, dev);
        if (hipFuncSetAttribute((const void*)yoco_fwd, hipFuncAttributeMaxDynamicSharedMemorySize, LDS_BYTES) != hipSuccess) { fprintf(stderr, "kernel_launch: hipFuncSetAttribute failed\n"); grid = -1; return; }
        if (hipOccupancyMaxActiveBlocksPerMultiprocessor(&per_cu, (const void*)yoco_fwd, 512, LDS_BYTES) != hipSuccess || per_cu < 1) { fprintf(stderr, "kernel_launch: occupancy query says %d blocks per CU\n", per_cu); per_cu = 1; }
        (void)hipGetLastError();
        grid = cus;
    }
    if (grid < 0) return;
    Params p{};
    for (int i = 0; i < 23; ++i) p.in[i] = (const float*)d_in[i];
    p.out = (float*)d_out; p.ws = (unsigned char*)d_ws;
    if (hipMemsetAsync((char*)d_ws + WS_BAR, 0, 65536, stream) != hipSuccess) { fprintf(stderr, "kernel_launch: memset of the control words failed\n"); return; }
#if N_LAUNCHES == 1
    p.ph_lo = 0; p.ph_hi = NPHASE;
    void* args[] = {&p};
    hipError_t e = hipLaunchCooperativeKernel((const void*)yoco_fwd, dim3(grid), dim3(512), args, LDS_BYTES, stream);
    if (e != hipSuccess) fprintf(stderr, "cooperative launch failed: %s (grid %d)\n", hipGetErrorString(e), grid);
#else
    for (int ph = 0; ph < NPHASE; ++ph) { p.ph_lo = ph; p.ph_hi = ph + 1; hipLaunchKernelGGL(yoco_fwd, dim3(grid), dim3(512), LDS_BYTES, stream, p); }
#endif
}
```
